# Optimizing an MI355X kernel written in HIP

```python
import jax, jax.numpy as jnp
from jax import lax
import numpy as np

D_MODEL = 1024
BATCH = 8
SEQ = 2048
DEPTH = 2
DEC_BATCH = 128
DEC_SEQ = 1
PAST_LEN = 16384
PAGE_SIZE = 128

CHUNK = 128
A_GROUPS = 4
A_WIDTH = D_MODEL // 4
A_KERNEL = 3
B_HEADS = 4
B_HEAD_DIM = D_MODEL // 8
B_WIDTH = B_HEADS * B_HEAD_DIM
C_GROUPS = 4
C_WIDTH = D_MODEL // 4
C_KERNEL = 31
D_MIX = A_WIDTH + B_WIDTH + C_WIDTH
D_IN = 3 * A_WIDTH + 2 * B_WIDTH + 2 * C_WIDTH
SPLITS = [A_WIDTH, 2 * A_WIDTH, 3 * A_WIDTH,
          3 * A_WIDTH + B_WIDTH, 3 * A_WIDTH + 2 * B_WIDTH,
          3 * A_WIDTH + 2 * B_WIDTH + C_WIDTH]
D_FF = 256 * ((8 * D_MODEL // 3 + 255) // 256)
PLE_DIM = 256
EPS = 1e-6

kernel_name = "hybrid_conv_gmlp_conformer_decode_step"


def rms_norm(x, g):
    xf = x.astype(jnp.float32)
    y = xf * lax.rsqrt(jnp.mean(xf * xf, axis=-1, keepdims=True) + EPS)
    return (y * g.astype(jnp.float32)).astype(x.dtype)


def layer_norm(x, g, b):
    xf = x.astype(jnp.float32)
    mu = jnp.mean(xf, axis=-1, keepdims=True)
    xc = xf - mu
    var = jnp.mean(xc * xc, axis=-1, keepdims=True)
    y = xc * lax.rsqrt(var + EPS) * g.astype(jnp.float32) + b.astype(jnp.float32)
    return y.astype(x.dtype)


def swiglu(h, wg, wu, wd):
    return (jax.nn.silu(h @ wg) * (h @ wu)) @ wd


def depthwise_causal_conv(full, w):
    c = w.shape[1]
    return lax.conv_general_dilated(full, w[:, None, :], window_strides=(1,), padding='VALID',
                                    dimension_numbers=('NWC', 'WIO', 'NWC'),
                                    feature_group_count=c)


def chunk_spatial_mix(v, ws, bias):
    n, t, h, d = v.shape
    L = min(t, CHUNK)
    mask = jnp.tril(jnp.ones((L, L), dtype=bool))
    w = jnp.where(mask[None], ws[:, :L, :L], 0)
    vc = v.reshape(n, t // L, L, h, d)
    out = jnp.einsum('hij,ncjhd->ncihd', w, vc)
    out = out + jnp.swapaxes(bias[:, :L], 0, 1)[None, None, :, :, None]
    return out.reshape(n, t, h, d)


def trunk_layer(x, p, hist_a, hist_c, lw):
    (f1_pre, f1_post, f1_wg, f1_wu, f1_wd, m_pre, m_post, w_in, w_out, a_cw,
     b_lng, b_lnb, b_ws, b_bias, c_cw, c_cb, c_lng, c_lnb,
     f2_pre, f2_post, f2_wg, f2_wu, f2_wd, e_pre, e_post, e_wg, e_wp) = lw
    n, t, _ = x.shape
    x = x + 0.5 * rms_norm(swiglu(rms_norm(x, f1_pre), f1_wg, f1_wu, f1_wd), f1_post)
    h = rms_norm(x, m_pre)
    z = h @ w_in
    a_val, a_c, a_b, b_u, b_v, c_val, c_gate = jnp.split(z, SPLITS, axis=-1)
    fa = jnp.concatenate([hist_a, a_c * a_val], axis=1)
    y_a = a_b * depthwise_causal_conv(fa, a_cw)
    new_a = fa[:, -(A_KERNEL - 1):]
    u = jax.nn.gelu(b_u)
    v = layer_norm(jax.nn.gelu(b_v).reshape(n, t, B_HEADS, B_HEAD_DIM), b_lng, b_lnb)
    y_b = u * chunk_spatial_mix(v, b_ws, b_bias).reshape(n, t, B_WIDTH)
    fc = jnp.concatenate([hist_c, c_val * jax.nn.sigmoid(c_gate)], axis=1)
    y_c = jax.nn.silu(layer_norm(depthwise_causal_conv(fc, c_cw) + c_cb, c_lng, c_lnb))
    new_c = fc[:, -(C_KERNEL - 1):]
    mix = jnp.concatenate([y_a, y_b, y_c], axis=-1) @ w_out
    x = x + rms_norm(mix, m_post)
    x = x + 0.5 * rms_norm(swiglu(rms_norm(x, f2_pre), f2_wg, f2_wu, f2_wd), f2_post)
    gate = jax.nn.sigmoid(rms_norm(x, e_pre) @ e_wg)
    x = x + rms_norm(gate * (p @ e_wp), e_post)
    return x, new_a, new_c, v.reshape(n, t, B_WIDTH)


def setup_inputs(seed: int = 0) -> dict:
    key = jax.random.key(seed)
    keys = iter(jax.random.split(key, 48))

    def nrm(shape, scale):
        return jax.random.normal(next(keys), shape, jnp.float32) * scale

    def gain(shape):
        return 1.0 + nrm(shape, 0.05)

    L = DEPTH
    return {
        "x_prompt": nrm((BATCH, SEQ, D_MODEL), 1.0),
        "x_sample": nrm((DEC_BATCH, DEC_SEQ, D_MODEL), 1.0),
        "state_conv_a": nrm((L, DEC_BATCH, A_KERNEL - 1, A_WIDTH), 1.0),
        "state_conv_c": nrm((L, DEC_BATCH, C_KERNEL - 1, C_WIDTH), 1.0),
        "p_prompt": nrm((L, BATCH, SEQ, PLE_DIM), 1.0),
        "p_sample": nrm((L, DEC_BATCH, DEC_SEQ, PLE_DIM), 1.0),
        "f1_pre": gain((L, D_MODEL)),
        "f1_post": gain((L, D_MODEL)),
        "f1_wg": nrm((L, D_MODEL, D_FF), D_MODEL ** -0.5),
        "f1_wu": nrm((L, D_MODEL, D_FF), D_MODEL ** -0.5),
        "f1_wd": nrm((L, D_FF, D_MODEL), D_FF ** -0.5),
        "m_pre": gain((L, D_MODEL)),
        "m_post": gain((L, D_MODEL)),
        "w_in": nrm((L, D_MODEL, D_IN), D_MODEL ** -0.5),
        "w_out": nrm((L, D_MIX, D_MODEL), D_MIX ** -0.5),
        "a_conv_w": nrm((L, A_KERNEL, A_WIDTH), A_KERNEL ** -0.5),
        "b_ln_g": gain((L, B_HEADS, B_HEAD_DIM)),
        "b_ln_b": nrm((L, B_HEADS, B_HEAD_DIM), 0.02),
        "b_ws": nrm((L, B_HEADS, CHUNK, CHUNK), CHUNK ** -0.5),
        "b_bias": 1.0 + nrm((L, B_HEADS, CHUNK), 0.02),
        "c_conv_w": nrm((L, C_KERNEL, C_WIDTH), C_KERNEL ** -0.5),
        "c_conv_b": nrm((L, C_WIDTH), 0.02),
        "c_ln_g": gain((L, C_WIDTH)),
        "c_ln_b": nrm((L, C_WIDTH), 0.02),
        "f2_pre": gain((L, D_MODEL)),
        "f2_post": gain((L, D_MODEL)),
        "f2_wg": nrm((L, D_MODEL, D_FF), D_MODEL ** -0.5),
        "f2_wu": nrm((L, D_MODEL, D_FF), D_MODEL ** -0.5),
        "f2_wd": nrm((L, D_FF, D_MODEL), D_FF ** -0.5),
        "e_pre": gain((L, D_MODEL)),
        "e_post": gain((L, D_MODEL)),
        "e_wg": nrm((L, D_MODEL, D_MODEL), D_MODEL ** -0.5),
        "e_wp": nrm((L, PLE_DIM, D_MODEL), PLE_DIM ** -0.5),
    }


def reference(x_prompt, x_sample, state_conv_a, state_conv_c, p_prompt, p_sample,
              f1_pre, f1_post, f1_wg, f1_wu, f1_wd, m_pre, m_post, w_in, w_out, a_conv_w,
              b_ln_g, b_ln_b, b_ws, b_bias, c_conv_w, c_conv_b, c_ln_g, c_ln_b,
              f2_pre, f2_post, f2_wg, f2_wu, f2_wd, e_pre, e_post, e_wg, e_wp):
    zeros_a = jnp.zeros((x_prompt.shape[0], A_KERNEL - 1, A_WIDTH), x_prompt.dtype)
    zeros_c = jnp.zeros((x_prompt.shape[0], C_KERNEL - 1, C_WIDTH), x_prompt.dtype)
    yp, ys = x_prompt, x_sample
    a_p, c_p, a_s, c_s, v_s = [], [], [], [], []
    for i in range(DEPTH):
        lw = tuple(w[i] for w in (f1_pre, f1_post, f1_wg, f1_wu, f1_wd, m_pre, m_post, w_in,
                                  w_out, a_conv_w, b_ln_g, b_ln_b, b_ws, b_bias, c_conv_w,
                                  c_conv_b, c_ln_g, c_ln_b, f2_pre, f2_post, f2_wg, f2_wu,
                                  f2_wd, e_pre, e_post, e_wg, e_wp))
        yp, na_p, nc_p, _ = trunk_layer(yp, p_prompt[i], zeros_a, zeros_c, lw)
        ys, na_s, nc_s, vr_s = trunk_layer(ys, p_sample[i], state_conv_a[i], state_conv_c[i], lw)
        a_p.append(na_p)
        c_p.append(nc_p)
        a_s.append(na_s)
        c_s.append(nc_s)
        v_s.append(vr_s)
    return (yp, ys, jnp.stack(a_p), jnp.stack(c_p), jnp.stack(a_s), jnp.stack(c_s), jnp.stack(v_s))
```

```cpp
#include <hip/hip_runtime.h>
#include <hip/hip_cooperative_groups.h>
#include <cstdio>
#include <cstdint>
namespace cg = cooperative_groups;
namespace pg8 {
#define PG8_LAS __attribute__((address_space(3)))
typedef unsigned short bf16_t;
typedef short bf16x8 __attribute__((ext_vector_type(8)));
typedef float f32x4 __attribute__((ext_vector_type(4)));
typedef unsigned u32x4 __attribute__((ext_vector_type(4)));
constexpr int BM = 256, BK = 64, HALF = 128, HTB = HALF * BK * 2  , STAGE_BYTES = 8 * HTB, NXCD = 8, WGM = 8;

__host__ __device__ __forceinline__ int lds_byte(int r, int c) { const int st = (r >> 4) * 2 + (c >> 5), rr = r & 15, cc = c & 31, ob = rr * 64 + cc * 2; return st * 1024 + (ob ^ (((ob >> 9) & 1) << 5)); }
__host__ __device__ __forceinline__ void stage_rc(int b, int& R, int& C) { const int st = b / 1024, sb = b % 1024, swz = sb ^ (((sb >> 9) & 1) << 5); R = (st >> 1) * 16 + swz / 64; C = (st & 1) * 32 + (swz % 64) / 2; }
__host__ __device__ __forceinline__ int perm32(int rho) { const int n = rho >> 4, i = rho & 15; return 8 * (i >> 2) + 4 * n + (i & 3); }

struct Unit { int pm, pn; };
struct Gemm { const bf16_t* A; const bf16_t* Bt; int M, N, K; };

template <int M_, int N_> struct StaticOrderT {
    static constexpr int nM = M_ / BM, nN = N_ / BM, nwg = nM * nN;
    int G, c;
    __host__ __device__ void init(int G_, int c_) { G = G_; c = c_; }
    __host__ __device__ bool next(int i, Unit& u) const {
        const int L = i * G + c; if (L >= nwg) return false;
        int wgid = L; { constexpr int q = nwg / NXCD, r = nwg % NXCD; const int xcd = wgid % NXCD, off = wgid / NXCD; wgid = (xcd < r ? xcd * (q + 1) : r * (q + 1) + (xcd - r) * q) + off; }
        constexpr int nig = WGM * nN; const int gid = wgid / nig, fm = gid * WGM, gsz = (nM - fm) < WGM ? (nM - fm) : WGM;
        u.pm = fm + ((wgid % nig) % gsz); u.pn = (wgid % nig) / gsz; return true;
    }
    __device__ __forceinline__ void a_ready(const Unit&) const {}
    __device__ __forceinline__ void done(const Unit&) const {}
};

__device__ __forceinline__ unsigned cvt_pk_bf16(float lo, float hi) { unsigned r; asm volatile("v_cvt_pk_bf16_f32 %0, %1, %2" : "=v"(r) : "v"(lo), "v"(hi)); return r; }
typedef float f32x2 __attribute__((ext_vector_type(2)));
__device__ __forceinline__ f32x2 gelu_pk(f32x2 v) {
    const f32x2 av = __builtin_elementwise_abs(v), d = av * 0.2316418882f + 1.0f;
    f32x2 t; t.x = __builtin_amdgcn_rcpf(d.x); t.y = __builtin_amdgcn_rcpf(d.y);
    f32x2 q = t * 0.5307027145f + (-0.7265760135f); q = q * t + 0.7107068705f; q = q * t + (-0.142248368f); q = q * t + 0.127414796f; q = q * t;
    const f32x2 s = (v * v) * (-0.72134752044f);
    f32x2 e; e.x = __builtin_amdgcn_exp2f(s.x); e.y = __builtin_amdgcn_exp2f(s.y);
    const f32x2 m = v * (q * e), r = v - m;
    f32x2 o; o.x = v.x < 0.f ? m.x : r.x; o.y = v.y < 0.f ? m.y : r.y; return o;
}

template <int ACT  > struct EpiBf16 {
    static constexpr bool PERM = true, AFTER_DRAIN = false; static_assert(ACT == 0 || ACT == 1, "EpiBf16: ACT is 0 (none) or 1 (gelu_pk)");
    bf16_t* O; int ldc; const float* bias; int split_cols; size_t split_stride; float scale0;
    __device__ __forceinline__ void operator()(const f32x4 (&acc)[2][2][4][2], const Unit& u, int wr, int wc, int fr, int fq) const {
        const int row0 = u.pm * BM + wr * 64 + fr; int colt = u.pn * BM; bf16_t* base = O;
        float sc = 1.f; if (split_cols) { const int t = colt / split_cols; base += (size_t)t * split_stride; colt -= t * split_cols; if (t == 0) sc = scale0; }
        const int col0 = colt + wc * 32 + 8 * fq, bcol0 = u.pn * BM + wc * 32 + 8 * fq;
        f32x4 bv[2][2];
#pragma unroll
        for (int bj = 0; bj < 2; ++bj)
#pragma unroll
            for (int n = 0; n < 2; ++n) bv[bj][n] = bias ? *(const f32x4*)(bias + bcol0 + bj * HALF + 4 * n) : (f32x4){0.f, 0.f, 0.f, 0.f};
#pragma unroll
        for (int ai = 0; ai < 2; ++ai)
#pragma unroll
            for (int m = 0; m < 4; ++m) { bf16_t* rowp = base + (size_t)(row0 + ai * HALF + m * 16) * ldc + col0;
#pragma unroll
                for (int bj = 0; bj < 2; ++bj) { f32x4 v0 = acc[ai][bj][m][0] + bv[bj][0], v1 = acc[ai][bj][m][1] + bv[bj][1];
                    if (ACT == 1) { f32x2 a = gelu_pk((f32x2){v0[0], v0[1]}), b = gelu_pk((f32x2){v0[2], v0[3]}), c = gelu_pk((f32x2){v1[0], v1[1]}), d = gelu_pk((f32x2){v1[2], v1[3]});
                        v0 = (f32x4){a.x, a.y, b.x, b.y}; v1 = (f32x4){c.x, c.y, d.x, d.y}; }
                    v0 = v0 * sc; v1 = v1 * sc; u32x4 w; w.x = cvt_pk_bf16(v0[0], v0[1]); w.y = cvt_pk_bf16(v0[2], v0[3]); w.z = cvt_pk_bf16(v1[0], v1[1]); w.w = cvt_pk_bf16(v1[2], v1[3]);
                    *(u32x4*)(rowp + bj * HALF) = w; } }
    }
};
__device__ __forceinline__ float sigm(float x) { return __builtin_amdgcn_rcpf(1.f + __expf(-x)); }
struct EpiSwiGLU {
    static constexpr bool PERM = true, AFTER_DRAIN = false;
    bf16_t* O; int ldc;
    __device__ __forceinline__ void operator()(const f32x4 (&acc)[2][2][4][2], const Unit& u, int wr, int wc, int fr, int fq) const {
        const int row0 = u.pm * BM + wr * 64 + fr, col0 = u.pn * HALF + wc * 32 + 8 * fq;
#pragma unroll
        for (int ai = 0; ai < 2; ++ai)
#pragma unroll
            for (int m = 0; m < 4; ++m) { bf16_t* rowp = O + (size_t)(row0 + ai * HALF + m * 16) * ldc + col0;
                const f32x4 g0 = acc[ai][0][m][0], g1 = acc[ai][0][m][1], u0 = acc[ai][1][m][0], u1 = acc[ai][1][m][1];
                float r[8];
#pragma unroll
                for (int i = 0; i < 4; ++i) { r[i] = g0[i] * sigm(g0[i]) * u0[i]; r[4 + i] = g1[i] * sigm(g1[i]) * u1[i]; }
                u32x4 w; w.x = cvt_pk_bf16(r[0], r[1]); w.y = cvt_pk_bf16(r[2], r[3]); w.z = cvt_pk_bf16(r[4], r[5]); w.w = cvt_pk_bf16(r[6], r[7]);
                *(u32x4*)rowp = w; }
    }
};
struct EpiF32 {
    static constexpr bool PERM = false, AFTER_DRAIN = false;
    float* O; int ldc;
    __device__ __forceinline__ void operator()(const f32x4 (&acc)[2][2][4][2], const Unit& u, int wr, int wc, int fr, int fq) const {
        const int row0 = u.pm * BM + wr * 64 + fr, col0 = u.pn * BM + wc * 32 + 4 * fq;
#pragma unroll
        for (int ai = 0; ai < 2; ++ai)
#pragma unroll
            for (int m = 0; m < 4; ++m) { float* rowp = O + (size_t)(row0 + ai * HALF + m * 16) * ldc + col0;
#pragma unroll
                for (int bj = 0; bj < 2; ++bj)
#pragma unroll
                    for (int n = 0; n < 2; ++n) *(f32x4*)(rowp + bj * HALF + n * 16) = acc[ai][bj][m][n]; }
    }
};
struct EpiGate {
    static constexpr bool PERM = false, AFTER_DRAIN = false;
    float* O; const float* PE; int ldc;
    __device__ __forceinline__ void operator()(const f32x4 (&acc)[2][2][4][2], const Unit& u, int wr, int wc, int fr, int fq) const {
        const int row0 = u.pm * BM + wr * 64 + fr, col0 = u.pn * BM + wc * 32 + 4 * fq;
#pragma unroll
        for (int ai = 0; ai < 2; ++ai)
#pragma unroll
            for (int m = 0; m < 4; ++m) { const size_t off = (size_t)(row0 + ai * HALF + m * 16) * ldc + col0;
#pragma unroll
                for (int bj = 0; bj < 2; ++bj)
#pragma unroll
                    for (int n = 0; n < 2; ++n) { const f32x4 a = acc[ai][bj][m][n]; const f32x4 p = *(const f32x4*)(PE + off + bj * HALF + n * 16);
                        f32x4 o; o.x = sigm(a.x) * p.x; o.y = sigm(a.y) * p.y; o.z = sigm(a.z) * p.z; o.w = sigm(a.w) * p.w;
                        *(f32x4*)(O + off + bj * HALF + n * 16) = o; }
                asm volatile("" ::: "memory"); }
    }
};
template <class Epi, class Sched, bool ALIGN_EPI, bool SP2, int KC>
__device__ __forceinline__ void gemm_phase(PG8_LAS unsigned char* lds, const Gemm g, const Sched& S, const Epi& E) {
    int tid_ = threadIdx.x; asm volatile("" : "+v"(tid_));
    const int tid = tid_, wid = __builtin_amdgcn_readfirstlane(tid >> 6), lane = tid & 63, wr = wid >> 2, wc = wid & 3, fr = lane & 15, fq = lane >> 4;
    const int K = g.K, nt = K / BK;
    unsigned voffA[2], voffB[2];
#pragma unroll
    for (int i = 0; i < 2; ++i) { int R, C; stage_rc(tid * 16 + i * 8192, R, C); const int Rb = Epi::PERM ? ((R & ~31) + perm32(R & 31)) : R;
        voffA[i] = (unsigned)(R * K + C) * 2u; voffB[i] = (unsigned)(Rb * K + C) * 2u; }
    const size_t kstep = (size_t)(BK * 2);
    const size_t hstep = (size_t)HALF * K * 2;
    const size_t tstep = 2 * hstep;
    const unsigned ldsw = (unsigned)wid * 1024u;
    const int aoff = lds_byte(wr * 64 + fr, fq * 8), boff = lds_byte(wc * 32 + fr, fq * 8);
#define PG8_SA(b, h) (((b) * 2 + (h)) * HTB)
#define PG8_SB(b, h) ((4 + (b) * 2 + (h)) * HTB)
#define PG8_STAGE(bufoff, gbase, voff) do { _Pragma("unroll") for (int _i = 0; _i < 2; ++_i) \
        __builtin_amdgcn_global_load_lds((const unsigned*)((const char*)(gbase) + (voff)[_i]), (PG8_LAS unsigned*)(lds + (bufoff) + ldsw + _i * 8192), 16, 0, 0); } while (0)
#define PG8_LDA(dst, b, h) do { _Pragma("unroll") for (int m = 0; m < 4; ++m) _Pragma("unroll") for (int k = 0; k < 2; ++k) dst[m][k] = *(const PG8_LAS bf16x8*)(lds + PG8_SA(b, h) + aoff + m * 2048 + k * 1024); } while (0)
#define PG8_LDB(dst, b, h) do { _Pragma("unroll") for (int n = 0; n < 2; ++n) _Pragma("unroll") for (int k = 0; k < 2; ++k) dst[n][k] = *(const PG8_LAS bf16x8*)(lds + PG8_SB(b, h) + boff + n * 2048 + k * 1024); } while (0)
#define PG8_MMA(ai, bj, At, Bt) do { __builtin_amdgcn_s_setprio(1); _Pragma("unroll") for (int m = 0; m < 4; ++m) _Pragma("unroll") for (int n = 0; n < 2; ++n) _Pragma("unroll") for (int k = 0; k < 2; ++k) \
        acc[ai][bj][m][n] = __builtin_amdgcn_mfma_f32_16x16x32_bf16(Bt[n][k], At[m][k], acc[ai][bj][m][n], 0, 0, 0); __builtin_amdgcn_s_setprio(0); } while (0)
#define PG8_WAIT_V(n) asm volatile("s_waitcnt vmcnt(" #n ")" ::: "memory")
#define PG8_WAIT_L(n) asm volatile("s_waitcnt lgkmcnt(" #n ")" ::: "memory")
#define PG8_BAR __builtin_amdgcn_s_barrier()
#define PG8_SCHED __builtin_amdgcn_sched_barrier(0)
    Unit cur, nxt; int ui = 0;
    if (!S.next(0, cur)) return;
    f32x4 acc[2][2][4][2];
#pragma unroll
    for (int a = 0; a < 2; ++a)
#pragma unroll
        for (int b = 0; b < 2; ++b)
#pragma unroll
            for (int m = 0; m < 4; ++m)
#pragma unroll
                for (int n = 0; n < 2; ++n) acc[a][b][m][n] = (f32x4){0.f, 0.f, 0.f, 0.f};
    bf16x8 At[4][2], B0[2][2], B1[2][2];
    const char* cA = (const char*)g.A + (size_t)cur.pm * tstep; const char* cB = (const char*)g.Bt + (size_t)cur.pn * tstep;
    S.a_ready(cur);
    if constexpr (SP2) {
        PG8_STAGE(PG8_SB(0, 0), cB, voffB); PG8_STAGE(PG8_SB(0, 1), cB + hstep, voffB); PG8_STAGE(PG8_SA(0, 0), cA, voffA); PG8_STAGE(PG8_SA(0, 1), cA + hstep, voffA);
        if (wr == 1) PG8_BAR;
        PG8_WAIT_V(2); PG8_BAR;
        PG8_STAGE(PG8_SB(1, 0), cB + kstep, voffB); PG8_STAGE(PG8_SA(1, 0), cA + kstep, voffA); PG8_STAGE(PG8_SB(1, 1), cB + hstep + kstep, voffB);
        PG8_WAIT_V(6); PG8_BAR;
    } else {
        PG8_STAGE(PG8_SB(0, 0), cB, voffB); PG8_STAGE(PG8_SA(0, 0), cA, voffA); PG8_STAGE(PG8_SB(0, 1), cB + hstep, voffB); PG8_STAGE(PG8_SA(0, 1), cA + hstep, voffA);
        if (wr == 1) PG8_BAR;
        PG8_WAIT_V(4); PG8_BAR;
        PG8_STAGE(PG8_SB(1, 0), cB + kstep, voffB); PG8_STAGE(PG8_SA(1, 0), cA + kstep, voffA); PG8_STAGE(PG8_SB(1, 1), cB + hstep + kstep, voffB);
        PG8_WAIT_V(6); PG8_BAR;
    }
    for (;;) {
        const bool has_next = S.next(ui + 1, nxt);
        const char* nA = has_next ? (const char*)g.A + (size_t)nxt.pm * tstep : cA; const char* nB = has_next ? (const char*)g.Bt + (size_t)nxt.pn * tstep : cB;
        for (int t = 0; t < nt; t += 2) {
            const bool last = (t == nt - 2);
            const char* a1 = cA + (size_t)(t + 1) * kstep;
            const char* a2 = last ? nA : cA + (size_t)(t + 2) * kstep; const char* b2 = last ? nB : cB + (size_t)(t + 2) * kstep;
            const char* a3 = a2 + kstep; const char* b3 = b2 + kstep;
            if (last && has_next) S.a_ready(nxt);
            if constexpr (SP2) {
            PG8_LDB(B0, 0, 0); PG8_LDB(B1, 0, 1); PG8_SCHED; PG8_LDA(At, 0, 0); PG8_STAGE(PG8_SA(1, 1), a1 + hstep, voffA);
            PG8_WAIT_V(8); PG8_WAIT_L(0); PG8_BAR; PG8_MMA(0, 0, At, B0); PG8_MMA(0, 1, At, B1); PG8_BAR; PG8_SCHED;
            PG8_LDA(At, 0, 1); PG8_STAGE(PG8_SB(0, 0), b2, voffB); PG8_STAGE(PG8_SB(0, 1), b2 + hstep, voffB); PG8_STAGE(PG8_SA(0, 0), a2, voffA);
            PG8_WAIT_V(8); PG8_WAIT_L(0); PG8_BAR; PG8_MMA(1, 0, At, B0); PG8_MMA(1, 1, At, B1); PG8_BAR; PG8_SCHED;
            PG8_LDB(B0, 1, 0); PG8_LDB(B1, 1, 1); PG8_SCHED; PG8_LDA(At, 1, 0); PG8_STAGE(PG8_SA(0, 1), a2 + hstep, voffA);
            PG8_WAIT_V(8); PG8_WAIT_L(0); PG8_BAR; PG8_MMA(0, 0, At, B0); PG8_MMA(0, 1, At, B1); PG8_BAR; PG8_SCHED;
            PG8_LDA(At, 1, 1); PG8_STAGE(PG8_SB(1, 0), b3, voffB); PG8_STAGE(PG8_SB(1, 1), b3 + hstep, voffB); PG8_STAGE(PG8_SA(1, 0), a3, voffA);
            PG8_WAIT_V(8); PG8_WAIT_L(0); PG8_BAR; PG8_MMA(1, 0, At, B0); PG8_MMA(1, 1, At, B1); PG8_BAR; PG8_SCHED;
            } else {
            PG8_LDB(B0, 0, 0); PG8_SCHED; PG8_LDA(At, 0, 0); PG8_STAGE(PG8_SA(1, 1), a1 + hstep, voffA);
            PG8_WAIT_L(8); PG8_BAR; PG8_WAIT_L(0); PG8_MMA(0, 0, At, B0); PG8_BAR; PG8_SCHED;
            PG8_LDB(B1, 0, 1); PG8_STAGE(PG8_SB(0, 0), b2, voffB);
            PG8_BAR; PG8_WAIT_L(0); PG8_MMA(0, 1, At, B1); PG8_BAR;
            PG8_LDA(At, 0, 1); PG8_STAGE(PG8_SA(0, 0), a2, voffA);
            PG8_BAR; PG8_WAIT_L(0); PG8_MMA(1, 0, At, B0); PG8_BAR; PG8_SCHED;
            PG8_STAGE(PG8_SB(0, 1), b2 + hstep, voffB);
            PG8_WAIT_V(6); PG8_BAR; PG8_MMA(1, 1, At, B1); PG8_BAR;
            PG8_LDB(B0, 1, 0); PG8_SCHED; PG8_LDA(At, 1, 0); PG8_STAGE(PG8_SA(0, 1), a2 + hstep, voffA);
            PG8_WAIT_L(8); PG8_BAR; PG8_WAIT_L(0); PG8_MMA(0, 0, At, B0); PG8_BAR; PG8_SCHED;
            PG8_LDB(B1, 1, 1); PG8_STAGE(PG8_SB(1, 0), b3, voffB);
            PG8_BAR; PG8_WAIT_L(0); PG8_MMA(0, 1, At, B1); PG8_BAR;
            PG8_LDA(At, 1, 1); PG8_STAGE(PG8_SA(1, 0), a3, voffA);
            PG8_BAR; PG8_WAIT_L(0); PG8_MMA(1, 0, At, B0); PG8_BAR; PG8_SCHED;
            PG8_STAGE(PG8_SB(1, 1), b3 + hstep, voffB);
            PG8_WAIT_V(6); PG8_BAR; PG8_MMA(1, 1, At, B1); PG8_BAR;
            }
        }
        if constexpr (ALIGN_EPI) { if (wr == 0) PG8_BAR; }
        if constexpr (!Epi::AFTER_DRAIN) { E(acc, cur, wr, wc, fr, fq); S.done(cur); }
        if (!has_next) break;
#pragma unroll
        for (int a = 0; a < 2; ++a)
#pragma unroll
            for (int b = 0; b < 2; ++b)
#pragma unroll
                for (int m = 0; m < 4; ++m)
#pragma unroll
                    for (int n = 0; n < 2; ++n) acc[a][b][m][n] = (f32x4){0.f, 0.f, 0.f, 0.f};
        cur = nxt; cA = nA; cB = nB; ++ui;
        if constexpr (ALIGN_EPI) { if (wr == 1) PG8_BAR; }
    }
    PG8_WAIT_V(0);
    if constexpr (!ALIGN_EPI) { if (wr == 0) PG8_BAR; }
    PG8_BAR;
    if constexpr (Epi::AFTER_DRAIN) { E.fused(acc, cur, wr, wc, fr, fq, lds, wid, lane); S.done(cur); }
#undef PG8_SA
#undef PG8_SB
#undef PG8_STAGE
#undef PG8_LDA
#undef PG8_LDB
#undef PG8_MMA
#undef PG8_WAIT_V
#undef PG8_WAIT_L
#undef PG8_BAR
#undef PG8_SCHED
}
}
#define GAS __attribute__((address_space(1)))
#define LAS __attribute__((address_space(3)))
typedef unsigned short bf16;
typedef unsigned v4u __attribute__((ext_vector_type(4)));
typedef unsigned v2u __attribute__((ext_vector_type(2)));
typedef float f32x4 __attribute__((ext_vector_type(4)));
typedef float f32x2 __attribute__((ext_vector_type(2)));
#define LDS_WAIT() asm volatile("s_waitcnt lgkmcnt(0)" ::: "memory")

constexpr int NWAVES = 8, NTHR = 512;
constexpr int DM = 1024, NBATCH = 8, SEQ = 2048, MP = NBATCH * SEQ, MS = 128, MV = MP + MS, MPAD = 16640;
constexpr int DFF = 2816, DIN = 2304, PLE = 256, NGU = 2 * DFF;
constexpr float EPS = 1e-6f;
constexpr size_t O_YP = 0, O_YS = (size_t)MP * DM, O_CAP = O_YS + (size_t)MS * DM, O_CCP = O_CAP + 2 * 8 * 2 * 256, O_CAS = O_CCP + 2 * 8 * 30 * 256,
                 O_CCS = O_CAS + 2 * 128 * 2 * 256, O_VS = O_CCS + (size_t)2 * 128 * 30 * 256;
constexpr size_t MiB = 1u << 20;
constexpr size_t WS_CTL = 0, CTL_ZERO_BYTES = 1 * MiB;
constexpr size_t WS_W = 1 * MiB;
constexpr size_t SZ_GU = (size_t)NGU * DM * 2, SZ_D = (size_t)DM * DFF * 2, SZ_IN = (size_t)DIN * DM * 2, SZ_SQ = (size_t)DM * DM * 2, SZ_EP = (size_t)DM * PLE * 2, SZ_WSM = 4 * 128 * 128 * 4;
constexpr size_t WS_GU0 = WS_W, WS_D0 = WS_GU0 + SZ_GU, WS_GU1 = WS_D0 + SZ_D, WS_D1 = WS_GU1 + SZ_GU, WS_IN = WS_D1 + SZ_D, WS_OUT = WS_IN + SZ_IN, WS_EG = WS_OUT + SZ_SQ, WS_EP = WS_EG + SZ_SQ,
                 WS_WSM = WS_EP + SZ_EP, WS_WEND = WS_WSM + 2 * SZ_WSM;
constexpr size_t WS_XN = 44 * MiB, WS_ACT = 77 * MiB, WS_Y = 167 * MiB, WS_PB = 232 * MiB, WS_END = 241 * MiB;
static_assert(WS_WEND <= WS_XN && WS_XN + (size_t)MPAD * DM * 2 <= WS_ACT && WS_ACT + (size_t)MPAD * DFF * 2 <= WS_Y && WS_Y + (size_t)MPAD * DM * 4 <= WS_PB && WS_PB + (size_t)MPAD * PLE * 2 <= WS_END, "ws map");
constexpr int LDS_BYTES = 131072 + 1024;

__device__ __forceinline__ unsigned f2bf(float f) { unsigned u = __builtin_bit_cast(unsigned, f); return (u + 0x7fffu + ((u >> 16) & 1u)) >> 16; }
__device__ __forceinline__ unsigned pk2(float lo, float hi) { return f2bf(lo) | (f2bf(hi) << 16); }
__device__ __forceinline__ float bf2f(unsigned h) { return __builtin_bit_cast(float, h << 16); }
__device__ __forceinline__ float wave_sum(float v) {
#pragma unroll
    for (int o = 1; o < 64; o <<= 1) v += __shfl_xor(v, o);
    return v;
}
__device__ __forceinline__ float sigm(float x) { return __builtin_amdgcn_rcpf(1.f + __expf(-x)); }
__device__ __forceinline__ float gelu_t(float x) { const float u = 0.7978845608f * (x + 0.044715f * x * x * x); const float e = __expf(2.f * u); const float t = 1.f - 2.f * __builtin_amdgcn_rcpf(1.f + e); return 0.5f * x * (1.f + t); }

struct Args { const float* in[33]; float* out; unsigned char* ws; };
enum { I_XP = 0, I_XS, I_SA, I_SC, I_PP, I_PS, I_F1PRE, I_F1POST, I_F1WG, I_F1WU, I_F1WD, I_MPRE, I_MPOST, I_WIN, I_WOUT, I_ACW, I_BLNG, I_BLNB, I_BWS, I_BBIAS,
       I_CCW, I_CCB, I_CLNG, I_CLNB, I_F2PRE, I_F2POST, I_F2WG, I_F2WU, I_F2WD, I_EPRE, I_EPOST, I_EWG, I_EWP };

typedef const __attribute__((address_space(4))) Args* ArgP;
__device__ __forceinline__ ArgP argp() { unsigned long long p = (unsigned long long)__builtin_amdgcn_kernarg_segment_ptr(); asm volatile("" : "+s"(p)); return (ArgP)p; }
struct Frame { LAS unsigned char* lds; int tid, lane, wave, G, bid; };

__device__ __forceinline__ Frame mkframe() { extern __shared__ __attribute__((aligned(16))) unsigned char lds_raw[]; Frame F; F.lds = (LAS unsigned char*)lds_raw; int t = threadIdx.x; asm volatile("" : "+v"(t)); F.tid = t; F.lane = t & 63; F.wave = __builtin_amdgcn_readfirstlane(t >> 6); F.G = gridDim.x; F.bid = blockIdx.x; return F; }
__device__ __forceinline__ void transpose_item(const float* W, int K, int N, bf16* WT, int mode, LAS float* scr, int item, int lane) {
    const int nblk = N / 32, kb = item / nblk, nb = item % nblk, k0 = 64 * kb, n0 = 32 * nb;
    const int d0 = mode == 0 ? n0 : ((n0 >> 7) * 256 + (n0 & 127) + (mode == 2 ? 128 : 0));
#pragma unroll 8
    for (int i = 0; i < 32; ++i) { const int kk = 2 * i + (lane >> 5); scr[kk * 33 + (lane & 31)] = W[(size_t)(k0 + kk) * N + n0 + (lane & 31)]; }
    LDS_WAIT(); asm volatile("" ::: "memory");
    const int c = lane & 7;
#pragma unroll
    for (int j = 0; j < 4; ++j) { const int n = (lane >> 3) + 8 * j; const LAS float* s = scr + (8 * c) * 33 + n;
        v4u o; o.x = pk2(s[0 * 33], s[1 * 33]); o.y = pk2(s[2 * 33], s[3 * 33]); o.z = pk2(s[4 * 33], s[5 * 33]); o.w = pk2(s[6 * 33], s[7 * 33]);
        *(v4u*)(WT + (size_t)(d0 + n) * K + k0 + 8 * c) = o; }
    LDS_WAIT(); asm volatile("" ::: "memory");
}

__device__ __forceinline__ void convert_layer(int l) {
    const Frame F = mkframe();
    unsigned char* ws = argp()->ws;
    LAS float* scr = (LAS float*)(F.lds + F.wave * 16384);
    const int gw = F.bid * NWAVES + F.wave, NGW = F.G * NWAVES;
    constexpr int I_GU = (DM / 64) * (DFF / 32), I_D = (DFF / 64) * (DM / 32), I_IN = (DM / 64) * (DIN / 32), I_SQ = (DM / 64) * (DM / 32), I_EP = (PLE / 64) * (DM / 32);
    constexpr int NITEMS = 6 * I_GU + I_IN + 2 * I_SQ + I_EP;
    static_assert(I_GU == I_D, "items");
    for (int it = gw; it < NITEMS; it += NGW) {
        int r = it, idx, K = DM, N = DM, mode = 0; size_t wsoff, srcoff;
        if (r < 6 * I_GU) { const int q = r / I_GU; r -= q * I_GU; const int ffn = q / 3, w = q % 3; idx = (ffn ? I_F2WG : I_F1WG) + w; srcoff = (size_t)l * DM * DFF;
            if (w == 2) { K = DFF; N = DM; wsoff = ffn ? WS_D1 : WS_D0; } else { K = DM; N = DFF; mode = w + 1; wsoff = ffn ? WS_GU1 : WS_GU0; } }
        else { r -= 6 * I_GU;
            if (r < I_IN) { idx = I_WIN; N = DIN; wsoff = WS_IN; srcoff = (size_t)l * DM * DIN; }
            else { r -= I_IN; srcoff = (size_t)l * DM * DM;
                if (r < I_SQ) { idx = I_WOUT; wsoff = WS_OUT; }
                else { r -= I_SQ; if (r < I_SQ) { idx = I_EWG; wsoff = WS_EG; } else { r -= I_SQ; idx = I_EWP; K = PLE; wsoff = WS_EP; srcoff = (size_t)l * PLE * DM; } } } }
        transpose_item(argp()->in[idx] + srcoff, K, N, (bf16*)(ws + wsoff), mode, scr, r, F.lane);
    }
    const int gt = F.bid * NTHR + F.tid, NGT = F.G * NTHR;
    { bf16* wsm = (bf16*)(ws + WS_WSM) + (size_t)l * 4 * 128 * 128; const float* src = argp()->in[I_BWS] + (size_t)l * 4 * 128 * 128;
      for (int e = gt; e < 4 * 128 * 128; e += NGT) { const int j = e & 127, i = (e >> 7) & 127; wsm[e] = (bf16)f2bf(j <= i ? src[e] : 0.f); } }
    { bf16* pb = (bf16*)(ws + WS_PB); const float* pp = argp()->in[I_PP] + (size_t)l * MP * PLE; const float* ps = argp()->in[I_PS] + (size_t)l * MS * PLE;
      for (int e = gt; e < MPAD * PLE / 4; e += NGT) { const int row = e >> 6, c4 = (e & 63) * 4;
          f32x4 v = (f32x4){0.f, 0.f, 0.f, 0.f};
          if (row < MP) v = *(const f32x4*)(pp + (size_t)row * PLE + c4); else if (row < MV) v = *(const f32x4*)(ps + (size_t)(row - MP) * PLE + c4);
          v2u o; o.x = pk2(v.x, v.y); o.y = pk2(v.z, v.w); *(v2u*)(pb + (size_t)row * PLE + c4) = o; } }
}

template <bool FIRST>
__device__ __forceinline__ void norm_pass(const float* y, float c, const float* gpost, const float* gpre) {
    const Frame F = mkframe();
    const int gw = F.bid * NWAVES + F.wave, NGW = F.G * NWAVES;
    bf16* XN = (bf16*)(argp()->ws + WS_XN);
    f32x4 gq[4], gp[4];
#pragma unroll
    for (int j = 0; j < 4; ++j) { gq[j] = *(const f32x4*)(gpre + 4 * F.lane + 256 * j); gp[j] = FIRST ? (f32x4){0.f, 0.f, 0.f, 0.f} : *(const f32x4*)(gpost + 4 * F.lane + 256 * j); }
    for (int row = gw; row < MV; row += NGW) {
        float* xo = argp()->out + (size_t)row * DM + 4 * F.lane;
        f32x4 xv[4];
        if (FIRST) { const float* xi = (row < MP ? argp()->in[I_XP] + (size_t)row * DM : argp()->in[I_XS] + (size_t)(row - MP) * DM) + 4 * F.lane;
#pragma unroll
            for (int j = 0; j < 4; ++j) xv[j] = *(const f32x4*)(xi + 256 * j);
        } else {
            const float* yr = y + (size_t)row * DM + 4 * F.lane; f32x4 yv[4]; float ss = 0.f;
#pragma unroll
            for (int j = 0; j < 4; ++j) { yv[j] = *(const f32x4*)(yr + 256 * j); xv[j] = *(const f32x4*)(xo + 256 * j); ss += (yv[j].x * yv[j].x + yv[j].y * yv[j].y) + (yv[j].z * yv[j].z + yv[j].w * yv[j].w); }
            const float r = c * rsqrtf(wave_sum(ss) * (1.f / DM) + EPS);
#pragma unroll
            for (int j = 0; j < 4; ++j) xv[j] = xv[j] + yv[j] * r * gp[j];
        }
        float s2 = 0.f;
#pragma unroll
        for (int j = 0; j < 4; ++j) { *(f32x4*)(xo + 256 * j) = xv[j]; s2 += (xv[j].x * xv[j].x + xv[j].y * xv[j].y) + (xv[j].z * xv[j].z + xv[j].w * xv[j].w); }
        const float r2 = rsqrtf(wave_sum(s2) * (1.f / DM) + EPS);
        bf16* xr = XN + (size_t)row * DM + 4 * F.lane;
#pragma unroll
        for (int j = 0; j < 4; ++j) { const f32x4 o = xv[j] * r2 * gq[j]; v2u w; w.x = pk2(o.x, o.y); w.y = pk2(o.z, o.w); *(v2u*)(xr + 256 * j) = w; }
    }
}

__device__ __forceinline__ void mix_b_unit(const Frame& F, int l, int ck, int h, const bf16* Z, bf16* MIXO) {
    typedef short bf16x8 __attribute__((ext_vector_type(8)));
    constexpr int VS = 136;
    LAS bf16* VT = (LAS bf16*)F.lds;
    const int t0 = ck * 128, lane = F.lane;
    { const f32x2 g = *(const f32x2*)(argp()->in[I_BLNG] + (l * 4 + h) * 128 + 2 * lane), b = *(const f32x2*)(argp()->in[I_BLNB] + (l * 4 + h) * 128 + 2 * lane);
#pragma unroll 2
      for (int i = 0; i < 16; ++i) { const int j = F.wave * 16 + i;
          const unsigned w = *(const unsigned*)(Z + (size_t)(t0 + j) * DIN + 1280 + h * 128 + 2 * lane);
          const float a0 = gelu_t(bf2f(w & 0xffffu)), a1 = gelu_t(bf2f(w >> 16));
          const float mean = wave_sum(a0 + a1) * (1.f / 128.f), d0 = a0 - mean, d1 = a1 - mean;
          const float rstd = rsqrtf(wave_sum(d0 * d0 + d1 * d1) * (1.f / 128.f) + EPS);
          VT[(2 * lane) * VS + j] = (bf16)f2bf(d0 * rstd * g.x + b.x); VT[(2 * lane + 1) * VS + j] = (bf16)f2bf(d1 * rstd * g.y + b.y); } }
    __syncthreads();
    const int i0 = F.wave * 16, fr = lane & 15, fq = lane >> 4, nk = (i0 + 16 + 31) >> 5;
    const bf16* Wb = (const bf16*)(argp()->ws + WS_WSM) + ((size_t)(l * 4 + h) * 128 + i0 + fr) * 128 + 8 * fq;
    f32x4 acc[8];
#pragma unroll
    for (int db = 0; db < 8; ++db) acc[db] = (f32x4){0.f, 0.f, 0.f, 0.f};
#pragma unroll 1
    for (int kb = 0; kb < nk; ++kb) {
        const bf16x8 wf = *(const bf16x8*)(Wb + kb * 32);
#pragma unroll
        for (int db = 0; db < 8; ++db) { const bf16x8 vf = *(const LAS bf16x8*)(VT + (db * 16 + fr) * VS + kb * 32 + 8 * fq);
            acc[db] = __builtin_amdgcn_mfma_f32_16x16x32_bf16(vf, wf, acc[db], 0, 0, 0); }
    }
    const float bi = argp()->in[I_BBIAS][(l * 4 + h) * 128 + i0 + fr];
    const size_t row = (size_t)(t0 + i0 + fr);
    const bf16* zu = Z + row * DIN + 768 + h * 128 + 4 * fq; bf16* mo = MIXO + row * DM + 256 + h * 128 + 4 * fq;
#pragma unroll
    for (int db = 0; db < 8; ++db) { const v2u uu = *(const v2u*)(zu + db * 16);
        const float y0 = gelu_t(bf2f(uu.x & 0xffffu)) * (acc[db].x + bi), y1 = gelu_t(bf2f(uu.x >> 16)) * (acc[db].y + bi), y2 = gelu_t(bf2f(uu.y & 0xffffu)) * (acc[db].z + bi), y3 = gelu_t(bf2f(uu.y >> 16)) * (acc[db].w + bi);
        v2u w; w.x = pk2(y0, y1); w.y = pk2(y2, y3); *(v2u*)(mo + db * 16) = w; }
    __syncthreads();
}

__device__ __forceinline__ void mix_ac_unit(const Frame& F, int l, int tb, const bf16* Z, bf16* MIXO) {
    const int t0 = tb * 64, b = t0 >> 11, pos0 = t0 & 2047, c = F.tid & 255, half = F.tid >> 8;
    { const float* cw = argp()->in[I_ACW] + l * 3 * 256; const float w0 = cw[c], w1 = cw[256 + c], w2 = cw[512 + c];
      const int ts = half * 32; float f2 = 0.f, f1 = 0.f;
      if (pos0 + ts - 2 >= 0) { const size_t row = (size_t)(t0 + ts - 2); f2 = bf2f(Z[row * DIN + 256 + c]) * bf2f(Z[row * DIN + c]); }
      if (pos0 + ts - 1 >= 0) { const size_t row = (size_t)(t0 + ts - 1); f1 = bf2f(Z[row * DIN + 256 + c]) * bf2f(Z[row * DIN + c]); }
      float* cap = argp()->out + O_CAP + (size_t)((l * 8 + b) * 2) * 256 + c;
      for (int i = 0; i < 32; ++i) { const size_t row = (size_t)(t0 + ts + i); const int p = pos0 + ts + i;
          const float av = bf2f(Z[row * DIN + c]), ac = bf2f(Z[row * DIN + 256 + c]), ab = bf2f(Z[row * DIN + 512 + c]);
          const float fa = ac * av; MIXO[row * DM + c] = (bf16)f2bf(ab * (w0 * f2 + w1 * f1 + w2 * fa));
          if (p >= SEQ - 2) cap[(p - (SEQ - 2)) * 256] = fa;
          f2 = f1; f1 = fa; } }
    LAS float* FC = (LAS float*)F.lds;
    { float* ccp = argp()->out + O_CCP + (size_t)((l * 8 + b) * 30) * 256 + c;
      for (int r = half; r < 94; r += 2) { const int p = pos0 - 30 + r; float fc = 0.f;
          if (p >= 0) { const size_t row = (size_t)(t0 - 30 + r); fc = bf2f(Z[row * DIN + 1792 + c]) * sigm(bf2f(Z[row * DIN + 2048 + c]));
              if (r >= 30 && p >= SEQ - 30) ccp[(p - (SEQ - 30)) * 256] = fc; }
          FC[r * 256 + c] = fc; } }
    __syncthreads();
    { const float* cw = argp()->in[I_CCW] + l * 31 * 256 + c; float w[31];
#pragma unroll
      for (int k = 0; k < 31; ++k) w[k] = cw[k * 256];
      float acc[32]; const float cb = argp()->in[I_CCB][l * 256 + c];
#pragma unroll
      for (int tt = 0; tt < 32; ++tt) acc[tt] = cb;
#pragma unroll
      for (int s = 0; s < 62; ++s) { const float f = FC[(half * 32 + s) * 256 + c];
#pragma unroll
          for (int tt = 0; tt < 32; ++tt) { if (s - tt >= 0 && s - tt <= 30) acc[tt] += w[s - tt] * f; } }
      __syncthreads();
#pragma unroll
      for (int tt = 0; tt < 32; ++tt) FC[(half * 32 + tt) * 256 + c] = acc[tt]; }
    __syncthreads();
    { const f32x4 g4 = *(const f32x4*)(argp()->in[I_CLNG] + l * 256 + 4 * F.lane), b4 = *(const f32x4*)(argp()->in[I_CLNB] + l * 256 + 4 * F.lane);
      for (int i = 0; i < 8; ++i) { const int t = F.wave * 8 + i; const f32x4 o = *(const LAS f32x4*)(FC + t * 256 + 4 * F.lane);
          const float mean = wave_sum((o.x + o.y) + (o.z + o.w)) * (1.f / 256.f); const f32x4 dd = o - mean;
          const float rstd = rsqrtf(wave_sum((dd.x * dd.x + dd.y * dd.y) + (dd.z * dd.z + dd.w * dd.w)) * (1.f / 256.f) + EPS);
          f32x4 yv = dd * rstd * g4 + b4; yv.x *= sigm(yv.x); yv.y *= sigm(yv.y); yv.z *= sigm(yv.z); yv.w *= sigm(yv.w);
          v2u w; w.x = pk2(yv.x, yv.y); w.y = pk2(yv.z, yv.w); *(v2u*)(MIXO + (size_t)(t0 + t) * DM + 768 + 4 * F.lane) = w; } }
    __syncthreads();
}

__device__ __forceinline__ void mix_sample_row(const Frame& F, int l, int s, const bf16* Z, bf16* MIXO) {
    const int lane = F.lane; const size_t R = (size_t)(MP + s); const bf16* z = Z + R * DIN; bf16* mo = MIXO + R * DM;
    {
      const int c = 4 * lane; const v2u zv = *(const v2u*)(z + c), zc = *(const v2u*)(z + 256 + c), zb = *(const v2u*)(z + 512 + c);
      const float* cw = argp()->in[I_ACW] + l * 3 * 256 + c; const f32x4 w0 = *(const f32x4*)cw, w1 = *(const f32x4*)(cw + 256), w2 = *(const f32x4*)(cw + 512);
      const float* st = argp()->in[I_SA] + ((size_t)(l * MS + s) * 2) * 256 + c; const f32x4 h0 = *(const f32x4*)st, h1 = *(const f32x4*)(st + 256);
      f32x4 av = {bf2f(zv.x & 0xffffu), bf2f(zv.x >> 16), bf2f(zv.y & 0xffffu), bf2f(zv.y >> 16)}, ac = {bf2f(zc.x & 0xffffu), bf2f(zc.x >> 16), bf2f(zc.y & 0xffffu), bf2f(zc.y >> 16)},
            ab = {bf2f(zb.x & 0xffffu), bf2f(zb.x >> 16), bf2f(zb.y & 0xffffu), bf2f(zb.y >> 16)};
      const f32x4 fa = ac * av, ya = ab * (w0 * h0 + w1 * h1 + w2 * fa);
      v2u w; w.x = pk2(ya.x, ya.y); w.y = pk2(ya.z, ya.w); *(v2u*)(mo + c) = w;
      float* cas = argp()->out + O_CAS + ((size_t)(l * MS + s) * 2) * 256 + c; *(f32x4*)cas = h1; *(f32x4*)(cas + 256) = fa; }
    {
      float* vs = argp()->out + O_VS + (size_t)(l * MS + s) * 512;
#pragma unroll
      for (int h = 0; h < 4; ++h) { const int d = 2 * lane;
          const unsigned wv = *(const unsigned*)(z + 1280 + h * 128 + d), wu = *(const unsigned*)(z + 768 + h * 128 + d);
          const f32x2 g = *(const f32x2*)(argp()->in[I_BLNG] + (l * 4 + h) * 128 + d), bb = *(const f32x2*)(argp()->in[I_BLNB] + (l * 4 + h) * 128 + d);
          const float a0 = gelu_t(bf2f(wv & 0xffffu)), a1 = gelu_t(bf2f(wv >> 16));
          const float mean = wave_sum(a0 + a1) * (1.f / 128.f), d0 = a0 - mean, d1 = a1 - mean;
          const float rstd = rsqrtf(wave_sum(d0 * d0 + d1 * d1) * (1.f / 128.f) + EPS);
          const float v0 = d0 * rstd * g.x + bb.x, v1 = d1 * rstd * g.y + bb.y;
          *(f32x2*)(vs + h * 128 + d) = (f32x2){v0, v1};
          const float w00 = argp()->in[I_BWS][(size_t)(l * 4 + h) * 128 * 128], bi = argp()->in[I_BBIAS][(l * 4 + h) * 128];
          const float y0 = gelu_t(bf2f(wu & 0xffffu)) * (w00 * v0 + bi), y1 = gelu_t(bf2f(wu >> 16)) * (w00 * v1 + bi);
          *(unsigned*)(mo + 256 + h * 128 + d) = pk2(y0, y1); } }
    {
      const int c = 4 * lane; const v2u zv = *(const v2u*)(z + 1792 + c), zg = *(const v2u*)(z + 2048 + c);
      f32x4 fc = {bf2f(zv.x & 0xffffu) * sigm(bf2f(zg.x & 0xffffu)), bf2f(zv.x >> 16) * sigm(bf2f(zg.x >> 16)), bf2f(zv.y & 0xffffu) * sigm(bf2f(zg.y & 0xffffu)), bf2f(zv.y >> 16) * sigm(bf2f(zg.y >> 16))};
      const float* cw = argp()->in[I_CCW] + l * 31 * 256 + c; const float* st = argp()->in[I_SC] + ((size_t)(l * MS + s) * 30) * 256 + c;
      float* ccs = argp()->out + O_CCS + ((size_t)(l * MS + s) * 30) * 256 + c;
      f32x4 acc = *(const f32x4*)(argp()->in[I_CCB] + l * 256 + c);
      for (int k = 0; k < 30; ++k) { const f32x4 hv = *(const f32x4*)(st + k * 256); acc = acc + *(const f32x4*)(cw + k * 256) * hv; if (k >= 1) *(f32x4*)(ccs + (k - 1) * 256) = hv; }
      acc = acc + *(const f32x4*)(cw + 30 * 256) * fc; *(f32x4*)(ccs + 29 * 256) = fc;
      const float mean = wave_sum((acc.x + acc.y) + (acc.z + acc.w)) * (1.f / 256.f); const f32x4 dd = acc - mean;
      const float rstd = rsqrtf(wave_sum((dd.x * dd.x + dd.y * dd.y) + (dd.z * dd.z + dd.w * dd.w)) * (1.f / 256.f) + EPS);
      f32x4 yv = dd * rstd * *(const f32x4*)(argp()->in[I_CLNG] + l * 256 + c) + *(const f32x4*)(argp()->in[I_CLNB] + l * 256 + c);
      yv.x *= sigm(yv.x); yv.y *= sigm(yv.y); yv.z *= sigm(yv.z); yv.w *= sigm(yv.w);
      v2u w; w.x = pk2(yv.x, yv.y); w.y = pk2(yv.z, yv.w); *(v2u*)(mo + 768 + c) = w; }
}

__device__ __forceinline__ void mixer_phase(int l) {
    const Frame F = mkframe();
    const bf16* Z = (const bf16*)(argp()->ws + WS_ACT); bf16* MIXO = (bf16*)(argp()->ws + WS_XN);
    constexpr int NB_U = 128 * 4, NAC_U = MP / 64, NS_U = MS / NWAVES, NU = NB_U + NAC_U + NS_U;
    for (int u = F.bid; u < NU; u += F.G) {
        const Frame Fu = mkframe(); asm volatile("" : "+s"(l));
        if (u < NB_U) {
#ifndef NO_MB
 mix_b_unit(Fu, l, u >> 2, u & 3, Z, MIXO);
#endif
 }
        else if (u < NB_U + NAC_U) {
#ifndef NO_MAC
 mix_ac_unit(Fu, l, u - NB_U, Z, MIXO);
#endif
 }
        else {
#ifndef NO_MS
 mix_sample_row(Fu, l, (u - NB_U - NAC_U) * NWAVES + Fu.wave, Z, MIXO);
#endif
 }
    }
}

#define GSYNC() grid.sync()
__global__ void __launch_bounds__(NTHR, 2) mega_fwd(Args a_unused) {
    extern __shared__ __attribute__((aligned(16))) unsigned char lds_raw[];
    cg::grid_group grid = cg::this_grid();
#define ws (argp()->ws)
#define XN ((bf16*)(ws + WS_XN))
#define ACT ((bf16*)(ws + WS_ACT))
#define Y ((float*)(ws + WS_Y))
#define PB ((bf16*)(ws + WS_PB))
#define PE ((float*)(ws + WS_ACT))
#ifndef NO_CONV
    convert_layer(0);
#endif
    { const Frame F = mkframe(); const int gt = F.bid * NTHR + F.tid, NGT = F.G * NTHR; v4u* p = (v4u*)(XN + (size_t)MV * DM);
      for (int e = gt; e < (MPAD - MV) * DM / 8; e += NGT) p[e] = (v4u){0u, 0u, 0u, 0u}; }
    norm_pass<true>(nullptr, 0.f, nullptr, argp()->in[I_F1PRE]);
    GSYNC();
#pragma unroll 1
    for (int l = 0; l < 2; ++l) {
#pragma unroll 1
        for (int f = 0; f < 2; ++f) {
            { pg8::Gemm g{XN, (const bf16*)(ws + (f ? WS_GU1 : WS_GU0)), MPAD, NGU, DM}; pg8::StaticOrderT<MPAD, NGU> S; S.init((int)gridDim.x, (int)blockIdx.x);
              pg8::EpiSwiGLU E{ACT, DFF};
              pg8::gemm_phase<pg8::EpiSwiGLU, pg8::StaticOrderT<MPAD, NGU>, true, true, DM>((LAS unsigned char*)lds_raw, g, S, E); }
            GSYNC();
            { pg8::Gemm g{ACT, (const bf16*)(ws + (f ? WS_D1 : WS_D0)), MPAD, DM, DFF}; pg8::StaticOrderT<MPAD, DM> S; S.init((int)gridDim.x, (int)blockIdx.x);
              pg8::EpiF32 E{Y, DM};
              pg8::gemm_phase<pg8::EpiF32, pg8::StaticOrderT<MPAD, DM>, true, true, DFF>((LAS unsigned char*)lds_raw, g, S, E); }
            GSYNC();
            if (f == 0) {
                norm_pass<false>(Y, 0.5f, argp()->in[I_F1POST] + l * DM, argp()->in[I_MPRE] + l * DM);
                GSYNC();
                { pg8::Gemm g{XN, (const bf16*)(ws + WS_IN), MPAD, DIN, DM}; pg8::StaticOrderT<MPAD, DIN> S; S.init((int)gridDim.x, (int)blockIdx.x);
                  pg8::EpiBf16<0> E{ACT, DIN, nullptr, 0, 0, 1.f};
                  pg8::gemm_phase<pg8::EpiBf16<0>, pg8::StaticOrderT<MPAD, DIN>, true, true, DM>((LAS unsigned char*)lds_raw, g, S, E); }
                GSYNC();
#ifndef NO_MIX
                mixer_phase(l);
#endif
                GSYNC();
                { pg8::Gemm g{XN, (const bf16*)(ws + WS_OUT), MPAD, DM, DM}; pg8::StaticOrderT<MPAD, DM> S; S.init((int)gridDim.x, (int)blockIdx.x);
                  pg8::EpiF32 E{Y, DM};
                  pg8::gemm_phase<pg8::EpiF32, pg8::StaticOrderT<MPAD, DM>, true, true, DM>((LAS unsigned char*)lds_raw, g, S, E); }
                GSYNC();
                norm_pass<false>(Y, 1.f, argp()->in[I_MPOST] + l * DM, argp()->in[I_F2PRE] + l * DM);
                GSYNC();
            } else {
                norm_pass<false>(Y, 0.5f, argp()->in[I_F2POST] + l * DM, argp()->in[I_EPRE] + l * DM);
                __syncthreads();
                { pg8::Gemm g{PB, (const bf16*)(ws + WS_EP), MPAD, DM, PLE}; pg8::StaticOrderT<MPAD, DM> S; S.init((int)gridDim.x, (int)blockIdx.x);
                  pg8::EpiF32 E{PE, DM};
                  pg8::gemm_phase<pg8::EpiF32, pg8::StaticOrderT<MPAD, DM>, true, true, PLE>((LAS unsigned char*)lds_raw, g, S, E); }
                GSYNC();
                { pg8::Gemm g{XN, (const bf16*)(ws + WS_EG), MPAD, DM, DM}; pg8::StaticOrderT<MPAD, DM> S; S.init((int)gridDim.x, (int)blockIdx.x);
                  pg8::EpiGate E{Y, PE, DM};
                  pg8::gemm_phase<pg8::EpiGate, pg8::StaticOrderT<MPAD, DM>, true, true, DM>((LAS unsigned char*)lds_raw, g, S, E); }
                GSYNC();
#ifndef NO_CONV
                if (l == 0) { __syncthreads(); convert_layer(1); }
#endif
                norm_pass<false>(Y, 1.f, argp()->in[I_EPOST] + l * DM, argp()->in[I_F1PRE] + (l == 0 ? DM : 0));
                GSYNC();
            }
        }
    }
}

#undef ws
#undef XN
#undef ACT
#undef Y
#undef PB
#undef PE
extern "C" void kernel_launch(void* const* d_in, const int* in_sizes, int n_in, void* d_out, int out_size, void* d_ws, size_t ws_size, hipStream_t stream) {
    static int grid = 0;
    if (grid == 0) {
        int dev = 0, cus = 0, per_cu = 0;
        if (n_in != 33 || ws_size < WS_END) { fprintf(stderr, "kernel_launch: unexpected n_in %d / ws_size %zu\n", n_in, ws_size); grid = -1; return; }
        hipGetDevice(&dev); hipDeviceGetAttribute(&cus, hipDeviceAttributeMultiprocessorCount, dev);
        if (hipFuncSetAttribute((const void*)mega_fwd, hipFuncAttributeMaxDynamicSharedMemorySize, LDS_BYTES) != hipSuccess) { fprintf(stderr, "kernel_launch: hipFuncSetAttribute failed\n"); grid = -1; return; }
        if (hipOccupancyMaxActiveBlocksPerMultiprocessor(&per_cu, (const void*)mega_fwd, NTHR, LDS_BYTES) != hipSuccess || per_cu < 1) { fprintf(stderr, "kernel_launch: occupancy query says %d\n", per_cu); grid = -1; return; }
        grid = cus;
    }
    if (grid < 0) return;
    hipMemsetAsync((char*)d_ws + WS_CTL, 0, CTL_ZERO_BYTES, stream);
    Args a{};
    for (int i = 0; i < 33; ++i) a.in[i] = (const float*)d_in[i];
    a.out = (float*)d_out; a.ws = (unsigned char*)d_ws;
    void* kargs[] = {&a};
    hipError_t e = hipLaunchCooperativeKernel((const void*)mega_fwd, dim3(grid), dim3(NTHR), kargs, LDS_BYTES, stream);
    if (e != hipSuccess) fprintf(stderr, "kernel_launch: cooperative launch failed: %s (grid %d)\n", hipGetErrorString(e), grid);
}
```

```cpp
#include <hip/hip_runtime.h>
#include <hip/hip_cooperative_groups.h>
#include <cstdio>
#include <cstdint>
namespace cg = cooperative_groups;
namespace pg8 {
#define PG8_LAS __attribute__((address_space(3)))
typedef unsigned short bf16_t;
typedef short bf16x8 __attribute__((ext_vector_type(8)));
typedef float f32x4 __attribute__((ext_vector_type(4)));
typedef unsigned u32x4 __attribute__((ext_vector_type(4)));
constexpr int BM = 256, BK = 64, HALF = 128, HTB = HALF * BK * 2  , STAGE_BYTES = 8 * HTB, NXCD = 8, WGM = 8;

__host__ __device__ __forceinline__ int lds_byte(int r, int c) { const int st = (r >> 4) * 2 + (c >> 5), rr = r & 15, cc = c & 31, ob = rr * 64 + cc * 2; return st * 1024 + (ob ^ (((ob >> 9) & 1) << 5)); }
__host__ __device__ __forceinline__ void stage_rc(int b, int& R, int& C) { const int st = b / 1024, sb = b % 1024, swz = sb ^ (((sb >> 9) & 1) << 5); R = (st >> 1) * 16 + swz / 64; C = (st & 1) * 32 + (swz % 64) / 2; }
__host__ __device__ __forceinline__ int perm32(int rho) { const int n = rho >> 4, i = rho & 15; return 8 * (i >> 2) + 4 * n + (i & 3); }

struct Unit { int pm, pn, ks; };
struct Gemm { const bf16_t* A; const bf16_t* Bt; int M, N, K, ld; };

template <int M_, int N_> struct StaticOrderT {
    static constexpr int nM = M_ / BM, nN = N_ / BM, nwg = nM * nN;
    int G, c;
    __host__ __device__ void init(int G_, int c_) { G = G_; c = c_; }
    __host__ __device__ bool next(int i, Unit& u) const {
        const int L = i * G + c; if (L >= nwg) return false;
        int wgid = L; { constexpr int q = nwg / NXCD, r = nwg % NXCD; const int xcd = wgid % NXCD, off = wgid / NXCD; wgid = (xcd < r ? xcd * (q + 1) : r * (q + 1) + (xcd - r) * q) + off; }
        constexpr int nig = WGM * nN; const int gid = wgid / nig, fm = gid * WGM, gsz = (nM - fm) < WGM ? (nM - fm) : WGM;
        u.pm = fm + ((wgid % nig) % gsz); u.pn = (wgid % nig) / gsz; u.ks = 0; return true;
    }
    __device__ __forceinline__ void a_ready(const Unit&) const {}
    __device__ __forceinline__ void done(const Unit&) const {}
};
template <int N_, int S_> struct SplitOrder {
    static constexpr int nN = N_ / BM, nwg = nN * S_;
    int G, c, pm0;
    __host__ __device__ void init(int G_, int c_, int pm0_) { G = G_; c = G_ - 1 - c_; pm0 = pm0_; }
    __host__ __device__ bool next(int i, Unit& u) const { const int L = i * G + c; if (L >= nwg) return false; u.pm = pm0; u.pn = L % nN; u.ks = L / nN; return true; }
    __device__ __forceinline__ void a_ready(const Unit&) const {}
    __device__ __forceinline__ void done(const Unit&) const {}
};

__device__ __forceinline__ unsigned cvt_pk_bf16(float lo, float hi) { unsigned r; asm volatile("v_cvt_pk_bf16_f32 %0, %1, %2" : "=v"(r) : "v"(lo), "v"(hi)); return r; }
typedef float f32x2 __attribute__((ext_vector_type(2)));
__device__ __forceinline__ f32x2 gelu_pk(f32x2 v) {
    const f32x2 av = __builtin_elementwise_abs(v), d = av * 0.2316418882f + 1.0f;
    f32x2 t; t.x = __builtin_amdgcn_rcpf(d.x); t.y = __builtin_amdgcn_rcpf(d.y);
    f32x2 q = t * 0.5307027145f + (-0.7265760135f); q = q * t + 0.7107068705f; q = q * t + (-0.142248368f); q = q * t + 0.127414796f; q = q * t;
    const f32x2 s = (v * v) * (-0.72134752044f);
    f32x2 e; e.x = __builtin_amdgcn_exp2f(s.x); e.y = __builtin_amdgcn_exp2f(s.y);
    const f32x2 m = v * (q * e), r = v - m;
    f32x2 o; o.x = v.x < 0.f ? m.x : r.x; o.y = v.y < 0.f ? m.y : r.y; return o;
}

template <int ACT  > struct EpiBf16 {
    static constexpr bool PERM = true, AFTER_DRAIN = false; static_assert(ACT == 0 || ACT == 1, "EpiBf16: ACT is 0 (none) or 1 (gelu_pk)");
    bf16_t* O; int ldc; const float* bias; int split_cols; size_t split_stride; float scale0;
    __device__ __forceinline__ void operator()(const f32x4 (&acc)[2][2][4][2], const Unit& u, int wr, int wc, int fr, int fq) const {
        const int row0 = u.pm * BM + wr * 64 + fr; int colt = u.pn * BM; bf16_t* base = O;
        float sc = 1.f; if (split_cols) { const int t = colt / split_cols; base += (size_t)t * split_stride; colt -= t * split_cols; if (t == 0) sc = scale0; }
        const int col0 = colt + wc * 32 + 8 * fq, bcol0 = u.pn * BM + wc * 32 + 8 * fq;
        f32x4 bv[2][2];
#pragma unroll
        for (int bj = 0; bj < 2; ++bj)
#pragma unroll
            for (int n = 0; n < 2; ++n) bv[bj][n] = bias ? *(const f32x4*)(bias + bcol0 + bj * HALF + 4 * n) : (f32x4){0.f, 0.f, 0.f, 0.f};
#pragma unroll
        for (int ai = 0; ai < 2; ++ai)
#pragma unroll
            for (int m = 0; m < 4; ++m) { bf16_t* rowp = base + (size_t)(row0 + ai * HALF + m * 16) * ldc + col0;
#pragma unroll
                for (int bj = 0; bj < 2; ++bj) { f32x4 v0 = acc[ai][bj][m][0] + bv[bj][0], v1 = acc[ai][bj][m][1] + bv[bj][1];
                    if (ACT == 1) { f32x2 a = gelu_pk((f32x2){v0[0], v0[1]}), b = gelu_pk((f32x2){v0[2], v0[3]}), c = gelu_pk((f32x2){v1[0], v1[1]}), d = gelu_pk((f32x2){v1[2], v1[3]});
                        v0 = (f32x4){a.x, a.y, b.x, b.y}; v1 = (f32x4){c.x, c.y, d.x, d.y}; }
                    v0 = v0 * sc; v1 = v1 * sc; u32x4 w; w.x = cvt_pk_bf16(v0[0], v0[1]); w.y = cvt_pk_bf16(v0[2], v0[3]); w.z = cvt_pk_bf16(v1[0], v1[1]); w.w = cvt_pk_bf16(v1[2], v1[3]);
                    *(u32x4*)(rowp + bj * HALF) = w; } }
    }
};
__device__ __forceinline__ float sigm(float x) { return __builtin_amdgcn_rcpf(1.f + __expf(-x)); }
struct EpiSwiGLU {
    static constexpr bool PERM = true, AFTER_DRAIN = false;
    bf16_t* O; int ldc;
    __device__ __forceinline__ void operator()(const f32x4 (&acc)[2][2][4][2], const Unit& u, int wr, int wc, int fr, int fq) const {
        int row0 = u.pm * BM + wr * 64 + fr; asm volatile("" : "+v"(row0)); const int col0 = u.pn * HALF + wc * 32 + 8 * fq;
#pragma unroll
        for (int ai = 0; ai < 2; ++ai)
#pragma unroll
            for (int m = 0; m < 4; ++m) { bf16_t* rowp = O + (size_t)(row0 + ai * HALF + m * 16) * ldc + col0;
                const f32x4 g0 = acc[ai][0][m][0], g1 = acc[ai][0][m][1], u0 = acc[ai][1][m][0], u1 = acc[ai][1][m][1];
                float r[8];
#pragma unroll
                for (int i = 0; i < 4; ++i) { r[i] = g0[i] * sigm(g0[i]) * u0[i]; r[4 + i] = g1[i] * sigm(g1[i]) * u1[i]; }
                u32x4 w; w.x = cvt_pk_bf16(r[0], r[1]); w.y = cvt_pk_bf16(r[2], r[3]); w.z = cvt_pk_bf16(r[4], r[5]); w.w = cvt_pk_bf16(r[6], r[7]);
                *(u32x4*)rowp = w; }
    }
};
struct EpiF32 {
    static constexpr bool PERM = false, AFTER_DRAIN = false;
    float* O; int ldc;
    __device__ __forceinline__ void operator()(const f32x4 (&acc)[2][2][4][2], const Unit& u, int wr, int wc, int fr, int fq) const {
        int row0 = u.pm * BM + wr * 64 + fr; asm volatile("" : "+v"(row0)); const int col0 = u.pn * BM + wc * 32 + 4 * fq;
#pragma unroll
        for (int ai = 0; ai < 2; ++ai)
#pragma unroll
            for (int m = 0; m < 4; ++m) { float* rowp = O + (size_t)(row0 + ai * HALF + m * 16) * ldc + col0;
#pragma unroll
                for (int bj = 0; bj < 2; ++bj)
#pragma unroll
                    for (int n = 0; n < 2; ++n) *(f32x4*)(rowp + bj * HALF + n * 16) = acc[ai][bj][m][n]; }
    }
};
struct EpiGate {
    static constexpr bool PERM = false, AFTER_DRAIN = false;
    float* O; const float* PE; int ldc;
    __device__ __forceinline__ void operator()(const f32x4 (&acc)[2][2][4][2], const Unit& u, int wr, int wc, int fr, int fq) const {
        int row0 = u.pm * BM + wr * 64 + fr; asm volatile("" : "+v"(row0)); const int col0 = u.pn * BM + wc * 32 + 4 * fq;
#pragma unroll
        for (int ai = 0; ai < 2; ++ai)
#pragma unroll
            for (int m = 0; m < 4; ++m) { const size_t off = (size_t)(row0 + ai * HALF + m * 16) * ldc + col0;
#pragma unroll
                for (int bj = 0; bj < 2; ++bj)
#pragma unroll
                    for (int n = 0; n < 2; ++n) { const f32x4 a = acc[ai][bj][m][n]; const f32x4 p = *(const f32x4*)(PE + off + bj * HALF + n * 16);
                        f32x4 o; o.x = sigm(a.x) * p.x; o.y = sigm(a.y) * p.y; o.z = sigm(a.z) * p.z; o.w = sigm(a.w) * p.w;
                        *(f32x4*)(O + off + bj * HALF + n * 16) = o; }
                asm volatile("" ::: "memory"); }
    }
};
struct EpiPart {
    static constexpr bool PERM = false, AFTER_DRAIN = false;
    float* O; int ldc;
    __device__ __forceinline__ void operator()(const f32x4 (&acc)[2][2][4][2], const Unit& u, int wr, int wc, int fr, int fq) const {
        int row0 = u.ks * BM + wr * 64 + fr; asm volatile("" : "+v"(row0)); const int col0 = u.pn * BM + wc * 32 + 4 * fq;
#pragma unroll
        for (int ai = 0; ai < 2; ++ai)
#pragma unroll
            for (int m = 0; m < 4; ++m) { float* rowp = O + (size_t)(row0 + ai * HALF + m * 16) * ldc + col0;
#pragma unroll
                for (int bj = 0; bj < 2; ++bj)
#pragma unroll
                    for (int n = 0; n < 2; ++n) *(f32x4*)(rowp + bj * HALF + n * 16) = acc[ai][bj][m][n]; }
    }
};
template <class Epi, class Sched, bool ALIGN_EPI, bool SP2, int KC>
__device__ __forceinline__ void gemm_phase(PG8_LAS unsigned char* lds, const Gemm g, const Sched& S, const Epi& E) {
    int tid_ = threadIdx.x; asm volatile("" : "+v"(tid_));
    const int tid = tid_, wid = __builtin_amdgcn_readfirstlane(tid >> 6), lane = tid & 63, wr = wid >> 2, wc = wid & 3, fr = lane & 15, fq = lane >> 4;
    const int K = g.ld, nt = g.K / BK;
    unsigned voffA[2], voffB[2];
#pragma unroll
    for (int i = 0; i < 2; ++i) { int R, C; stage_rc(tid * 16 + i * 8192, R, C); const int Rb = Epi::PERM ? ((R & ~31) + perm32(R & 31)) : R;
        voffA[i] = (unsigned)(R * K + C) * 2u; voffB[i] = (unsigned)(Rb * K + C) * 2u; }
    const size_t kstep = (size_t)(BK * 2);
    const size_t hstep = (size_t)HALF * K * 2;
    const size_t tstep = 2 * hstep;
    const unsigned ldsw = (unsigned)wid * 1024u;
    const int aoff = lds_byte(wr * 64 + fr, fq * 8), boff = lds_byte(wc * 32 + fr, fq * 8);
#define PG8_SA(b, h) (((b) * 2 + (h)) * HTB)
#define PG8_SB(b, h) ((4 + (b) * 2 + (h)) * HTB)
#define PG8_STAGE(bufoff, gbase, voff) do { _Pragma("unroll") for (int _i = 0; _i < 2; ++_i) \
        __builtin_amdgcn_global_load_lds((const unsigned*)((const char*)(gbase) + (voff)[_i]), (PG8_LAS unsigned*)(lds + (bufoff) + ldsw + _i * 8192), 16, 0, 0); } while (0)
#define PG8_LDA(dst, b, h) do { _Pragma("unroll") for (int m = 0; m < 4; ++m) _Pragma("unroll") for (int k = 0; k < 2; ++k) dst[m][k] = *(const PG8_LAS bf16x8*)(lds + PG8_SA(b, h) + aoff + m * 2048 + k * 1024); } while (0)
#define PG8_LDB(dst, b, h) do { _Pragma("unroll") for (int n = 0; n < 2; ++n) _Pragma("unroll") for (int k = 0; k < 2; ++k) dst[n][k] = *(const PG8_LAS bf16x8*)(lds + PG8_SB(b, h) + boff + n * 2048 + k * 1024); } while (0)
#define PG8_MMA(ai, bj, At, Bt) do { __builtin_amdgcn_s_setprio(1); _Pragma("unroll") for (int m = 0; m < 4; ++m) _Pragma("unroll") for (int n = 0; n < 2; ++n) _Pragma("unroll") for (int k = 0; k < 2; ++k) \
        acc[ai][bj][m][n] = __builtin_amdgcn_mfma_f32_16x16x32_bf16(Bt[n][k], At[m][k], acc[ai][bj][m][n], 0, 0, 0); __builtin_amdgcn_s_setprio(0); } while (0)
#define PG8_WAIT_V(n) asm volatile("s_waitcnt vmcnt(" #n ")" ::: "memory")
#define PG8_WAIT_L(n) asm volatile("s_waitcnt lgkmcnt(" #n ")" ::: "memory")
#define PG8_BAR __builtin_amdgcn_s_barrier()
#define PG8_SCHED __builtin_amdgcn_sched_barrier(0)
    Unit cur, nxt; int ui = 0;
    if (!S.next(0, cur)) return;
    f32x4 acc[2][2][4][2];
#pragma unroll
    for (int a = 0; a < 2; ++a)
#pragma unroll
        for (int b = 0; b < 2; ++b)
#pragma unroll
            for (int m = 0; m < 4; ++m)
#pragma unroll
                for (int n = 0; n < 2; ++n) acc[a][b][m][n] = (f32x4){0.f, 0.f, 0.f, 0.f};
    bf16x8 At[4][2], B0[2][2], B1[2][2];
    const char* cA = (const char*)g.A + (size_t)cur.pm * tstep + (size_t)cur.ks * (size_t)(g.K * 2); const char* cB = (const char*)g.Bt + (size_t)cur.pn * tstep + (size_t)cur.ks * (size_t)(g.K * 2);
    S.a_ready(cur);
    if constexpr (SP2) {
        PG8_STAGE(PG8_SB(0, 0), cB, voffB); PG8_STAGE(PG8_SB(0, 1), cB + hstep, voffB); PG8_STAGE(PG8_SA(0, 0), cA, voffA); PG8_STAGE(PG8_SA(0, 1), cA + hstep, voffA);
        if (wr == 1) PG8_BAR;
        PG8_WAIT_V(2); PG8_BAR;
        PG8_STAGE(PG8_SB(1, 0), cB + kstep, voffB); PG8_STAGE(PG8_SA(1, 0), cA + kstep, voffA); PG8_STAGE(PG8_SB(1, 1), cB + hstep + kstep, voffB);
        PG8_WAIT_V(6); PG8_BAR;
    } else {
        PG8_STAGE(PG8_SB(0, 0), cB, voffB); PG8_STAGE(PG8_SA(0, 0), cA, voffA); PG8_STAGE(PG8_SB(0, 1), cB + hstep, voffB); PG8_STAGE(PG8_SA(0, 1), cA + hstep, voffA);
        if (wr == 1) PG8_BAR;
        PG8_WAIT_V(4); PG8_BAR;
        PG8_STAGE(PG8_SB(1, 0), cB + kstep, voffB); PG8_STAGE(PG8_SA(1, 0), cA + kstep, voffA); PG8_STAGE(PG8_SB(1, 1), cB + hstep + kstep, voffB);
        PG8_WAIT_V(6); PG8_BAR;
    }
    for (;;) {
        const bool has_next = S.next(ui + 1, nxt);
        const char* nA = has_next ? (const char*)g.A + (size_t)nxt.pm * tstep + (size_t)nxt.ks * (size_t)(g.K * 2) : cA; const char* nB = has_next ? (const char*)g.Bt + (size_t)nxt.pn * tstep + (size_t)nxt.ks * (size_t)(g.K * 2) : cB;
        for (int t = 0; t < nt; t += 2) {
            const bool last = (t == nt - 2);
            const char* a1 = cA + (size_t)(t + 1) * kstep;
            const char* a2 = last ? nA : cA + (size_t)(t + 2) * kstep; const char* b2 = last ? nB : cB + (size_t)(t + 2) * kstep;
            const char* a3 = a2 + kstep; const char* b3 = b2 + kstep;
            if (last && has_next) S.a_ready(nxt);
            if constexpr (SP2) {
            PG8_LDB(B0, 0, 0); PG8_LDB(B1, 0, 1); PG8_SCHED; PG8_LDA(At, 0, 0); PG8_STAGE(PG8_SA(1, 1), a1 + hstep, voffA);
            PG8_WAIT_V(8); PG8_WAIT_L(0); PG8_BAR; PG8_MMA(0, 0, At, B0); PG8_MMA(0, 1, At, B1); PG8_BAR; PG8_SCHED;
            PG8_LDA(At, 0, 1); PG8_STAGE(PG8_SB(0, 0), b2, voffB); PG8_STAGE(PG8_SB(0, 1), b2 + hstep, voffB); PG8_STAGE(PG8_SA(0, 0), a2, voffA);
            PG8_WAIT_V(8); PG8_WAIT_L(0); PG8_BAR; PG8_MMA(1, 0, At, B0); PG8_MMA(1, 1, At, B1); PG8_BAR; PG8_SCHED;
            PG8_LDB(B0, 1, 0); PG8_LDB(B1, 1, 1); PG8_SCHED; PG8_LDA(At, 1, 0); PG8_STAGE(PG8_SA(0, 1), a2 + hstep, voffA);
            PG8_WAIT_V(8); PG8_WAIT_L(0); PG8_BAR; PG8_MMA(0, 0, At, B0); PG8_MMA(0, 1, At, B1); PG8_BAR; PG8_SCHED;
            PG8_LDA(At, 1, 1); PG8_STAGE(PG8_SB(1, 0), b3, voffB); PG8_STAGE(PG8_SB(1, 1), b3 + hstep, voffB); PG8_STAGE(PG8_SA(1, 0), a3, voffA);
            PG8_WAIT_V(8); PG8_WAIT_L(0); PG8_BAR; PG8_MMA(1, 0, At, B0); PG8_MMA(1, 1, At, B1); PG8_BAR; PG8_SCHED;
            } else {
            PG8_LDB(B0, 0, 0); PG8_SCHED; PG8_LDA(At, 0, 0); PG8_STAGE(PG8_SA(1, 1), a1 + hstep, voffA);
            PG8_WAIT_L(8); PG8_BAR; PG8_WAIT_L(0); PG8_MMA(0, 0, At, B0); PG8_BAR; PG8_SCHED;
            PG8_LDB(B1, 0, 1); PG8_STAGE(PG8_SB(0, 0), b2, voffB);
            PG8_BAR; PG8_WAIT_L(0); PG8_MMA(0, 1, At, B1); PG8_BAR;
            PG8_LDA(At, 0, 1); PG8_STAGE(PG8_SA(0, 0), a2, voffA);
            PG8_BAR; PG8_WAIT_L(0); PG8_MMA(1, 0, At, B0); PG8_BAR; PG8_SCHED;
            PG8_STAGE(PG8_SB(0, 1), b2 + hstep, voffB);
            PG8_WAIT_V(6); PG8_BAR; PG8_MMA(1, 1, At, B1); PG8_BAR;
            PG8_LDB(B0, 1, 0); PG8_SCHED; PG8_LDA(At, 1, 0); PG8_STAGE(PG8_SA(0, 1), a2 + hstep, voffA);
            PG8_WAIT_L(8); PG8_BAR; PG8_WAIT_L(0); PG8_MMA(0, 0, At, B0); PG8_BAR; PG8_SCHED;
            PG8_LDB(B1, 1, 1); PG8_STAGE(PG8_SB(1, 0), b3, voffB);
            PG8_BAR; PG8_WAIT_L(0); PG8_MMA(0, 1, At, B1); PG8_BAR;
            PG8_LDA(At, 1, 1); PG8_STAGE(PG8_SA(1, 0), a3, voffA);
            PG8_BAR; PG8_WAIT_L(0); PG8_MMA(1, 0, At, B0); PG8_BAR; PG8_SCHED;
            PG8_STAGE(PG8_SB(1, 1), b3 + hstep, voffB);
            PG8_WAIT_V(6); PG8_BAR; PG8_MMA(1, 1, At, B1); PG8_BAR;
            }
        }
        if constexpr (ALIGN_EPI) { if (wr == 0) PG8_BAR; }
        if constexpr (!Epi::AFTER_DRAIN) { E(acc, cur, wr, wc, fr, fq); S.done(cur); }
        if (!has_next) break;
#pragma unroll
        for (int a = 0; a < 2; ++a)
#pragma unroll
            for (int b = 0; b < 2; ++b)
#pragma unroll
                for (int m = 0; m < 4; ++m)
#pragma unroll
                    for (int n = 0; n < 2; ++n) acc[a][b][m][n] = (f32x4){0.f, 0.f, 0.f, 0.f};
        cur = nxt; cA = nA; cB = nB; ++ui;
        if constexpr (ALIGN_EPI) { if (wr == 1) PG8_BAR; }
    }
    PG8_WAIT_V(0);
    if constexpr (!ALIGN_EPI) { if (wr == 0) PG8_BAR; }
    PG8_BAR;
    if constexpr (Epi::AFTER_DRAIN) { E.fused(acc, cur, wr, wc, fr, fq, lds, wid, lane); S.done(cur); }
#undef PG8_SA
#undef PG8_SB
#undef PG8_STAGE
#undef PG8_LDA
#undef PG8_LDB
#undef PG8_MMA
#undef PG8_WAIT_V
#undef PG8_WAIT_L
#undef PG8_BAR
#undef PG8_SCHED
}
}
#define GAS __attribute__((address_space(1)))
#define LAS __attribute__((address_space(3)))
typedef unsigned short bf16;
typedef unsigned v4u __attribute__((ext_vector_type(4)));
typedef unsigned v2u __attribute__((ext_vector_type(2)));
typedef float f32x4 __attribute__((ext_vector_type(4)));
typedef float f32x2 __attribute__((ext_vector_type(2)));
#define LDS_WAIT() asm volatile("s_waitcnt lgkmcnt(0)" ::: "memory")

constexpr int NWAVES = 8, NTHR = 512;
constexpr int DM = 1024, NBATCH = 8, SEQ = 2048, MP = NBATCH * SEQ, MS = 128, MV = MP + MS, MPAD = 16640;
constexpr int DFF = 2816, DIN = 2304, PLE = 256, NGU = 2 * DFF;
constexpr float EPS = 1e-6f;
constexpr size_t O_YP = 0, O_YS = (size_t)MP * DM, O_CAP = O_YS + (size_t)MS * DM, O_CCP = O_CAP + 2 * 8 * 2 * 256, O_CAS = O_CCP + 2 * 8 * 30 * 256,
                 O_CCS = O_CAS + 2 * 128 * 2 * 256, O_VS = O_CCS + (size_t)2 * 128 * 30 * 256;
constexpr size_t MiB = 1u << 20;
constexpr size_t WS_CTL = 0, CTL_ZERO_BYTES = 1 * MiB;
constexpr size_t WS_W = 1 * MiB;
constexpr size_t SZ_GU = (size_t)NGU * DM * 2, SZ_D = (size_t)DM * DFF * 2, SZ_IN = (size_t)DIN * DM * 2, SZ_SQ = (size_t)DM * DM * 2, SZ_EP = (size_t)DM * PLE * 2, SZ_WSM = 4 * 128 * 128 * 4;
constexpr size_t WS_GU0 = WS_W, WS_D0 = WS_GU0 + SZ_GU, WS_GU1 = WS_D0 + SZ_D, WS_D1 = WS_GU1 + SZ_GU, WS_IN = WS_D1 + SZ_D, WS_OUT = WS_IN + SZ_IN, WS_EG = WS_OUT + SZ_SQ, WS_EP = WS_EG + SZ_SQ,
                 WS_WSM = WS_EP + SZ_EP, WS_WEND = WS_WSM + 2 * SZ_WSM;
constexpr size_t WS_XN = 44 * MiB, WS_ACT = 77 * MiB, WS_Y = 167 * MiB, WS_PB = 232 * MiB, WS_YS = 241 * MiB, WS_END = 253 * MiB;
static_assert(WS_WEND <= WS_XN && WS_XN + (size_t)MPAD * DM * 2 <= WS_ACT && WS_ACT + (size_t)MPAD * DFF * 2 <= WS_Y && WS_Y + (size_t)MPAD * DM * 4 <= WS_PB && WS_PB + (size_t)MPAD * PLE * 2 <= WS_YS && WS_YS + (size_t)11 * 256 * DM * 4 <= WS_END, "ws map");
constexpr int LDS_BYTES = 131072 + 1024;

__device__ __forceinline__ unsigned f2bf(float f) { unsigned u = __builtin_bit_cast(unsigned, f); return (u + 0x7fffu + ((u >> 16) & 1u)) >> 16; }
__device__ __forceinline__ unsigned pk2(float lo, float hi) { return f2bf(lo) | (f2bf(hi) << 16); }
__device__ __forceinline__ float bf2f(unsigned h) { return __builtin_bit_cast(float, h << 16); }
__device__ __forceinline__ float wave_sum(float v) {
#pragma unroll
    for (int o = 1; o < 64; o <<= 1) v += __shfl_xor(v, o);
    return v;
}
__device__ __forceinline__ float sigm(float x) { return __builtin_amdgcn_rcpf(1.f + __expf(-x)); }
__device__ __forceinline__ float gelu_t(float x) { const float u = 0.7978845608f * (x + 0.044715f * x * x * x); const float e = __expf(2.f * u); const float t = 1.f - 2.f * __builtin_amdgcn_rcpf(1.f + e); return 0.5f * x * (1.f + t); }

struct Args { const float* in[33]; float* out; unsigned char* ws; };
enum { I_XP = 0, I_XS, I_SA, I_SC, I_PP, I_PS, I_F1PRE, I_F1POST, I_F1WG, I_F1WU, I_F1WD, I_MPRE, I_MPOST, I_WIN, I_WOUT, I_ACW, I_BLNG, I_BLNB, I_BWS, I_BBIAS,
       I_CCW, I_CCB, I_CLNG, I_CLNB, I_F2PRE, I_F2POST, I_F2WG, I_F2WU, I_F2WD, I_EPRE, I_EPOST, I_EWG, I_EWP };

typedef const __attribute__((address_space(4))) Args* ArgP;
__device__ __forceinline__ ArgP argp() { unsigned long long p = (unsigned long long)__builtin_amdgcn_kernarg_segment_ptr(); asm volatile("" : "+s"(p)); return (ArgP)p; }
struct Frame { LAS unsigned char* lds; int tid, lane, wave, G, bid; };

__device__ __forceinline__ Frame mkframe() { extern __shared__ __attribute__((aligned(16))) unsigned char lds_raw[]; Frame F; F.lds = (LAS unsigned char*)lds_raw; int t = threadIdx.x; asm volatile("" : "+v"(t)); F.tid = t; F.lane = t & 63; F.wave = __builtin_amdgcn_readfirstlane(t >> 6); F.G = gridDim.x; F.bid = blockIdx.x; return F; }
__device__ __forceinline__ void transpose_item(const float* W, int K, int N, bf16* WT, int mode, LAS float* scr, int item, int lane) {
    const int nblk = N / 32, kb = item / nblk, nb = item % nblk, k0 = 64 * kb, n0 = 32 * nb;
    const int d0 = mode == 0 ? n0 : ((n0 >> 7) * 256 + (n0 & 127) + (mode == 2 ? 128 : 0));
#pragma unroll 8
    for (int i = 0; i < 32; ++i) { const int kk = 2 * i + (lane >> 5); scr[kk * 33 + (lane & 31)] = W[(size_t)(k0 + kk) * N + n0 + (lane & 31)]; }
    LDS_WAIT(); asm volatile("" ::: "memory");
    const int c = lane & 7;
#pragma unroll
    for (int j = 0; j < 4; ++j) { const int n = (lane >> 3) + 8 * j; const LAS float* s = scr + (8 * c) * 33 + n;
        v4u o; o.x = pk2(s[0 * 33], s[1 * 33]); o.y = pk2(s[2 * 33], s[3 * 33]); o.z = pk2(s[4 * 33], s[5 * 33]); o.w = pk2(s[6 * 33], s[7 * 33]);
        *(v4u*)(WT + (size_t)(d0 + n) * K + k0 + 8 * c) = o; }
    LDS_WAIT(); asm volatile("" ::: "memory");
}

__device__ __forceinline__ void convert_layer(int l) {
    const Frame F = mkframe();
    unsigned char* ws = argp()->ws;
    LAS float* scr = (LAS float*)(F.lds + F.wave * 16384);
    const int gw = F.bid * NWAVES + F.wave, NGW = F.G * NWAVES;
    constexpr int I_GU = (DM / 64) * (DFF / 32), I_D = (DFF / 64) * (DM / 32), I_IN = (DM / 64) * (DIN / 32), I_SQ = (DM / 64) * (DM / 32), I_EP = (PLE / 64) * (DM / 32);
    constexpr int NITEMS = 6 * I_GU + I_IN + 2 * I_SQ + I_EP;
    static_assert(I_GU == I_D, "items");
    for (int it = gw; it < NITEMS; it += NGW) {
        int r = it, idx, K = DM, N = DM, mode = 0; size_t wsoff, srcoff;
        if (r < 6 * I_GU) { const int q = r / I_GU; r -= q * I_GU; const int ffn = q / 3, w = q % 3; idx = (ffn ? I_F2WG : I_F1WG) + w; srcoff = (size_t)l * DM * DFF;
            if (w == 2) { K = DFF; N = DM; wsoff = ffn ? WS_D1 : WS_D0; } else { K = DM; N = DFF; mode = w + 1; wsoff = ffn ? WS_GU1 : WS_GU0; } }
        else { r -= 6 * I_GU;
            if (r < I_IN) { idx = I_WIN; N = DIN; wsoff = WS_IN; srcoff = (size_t)l * DM * DIN; }
            else { r -= I_IN; srcoff = (size_t)l * DM * DM;
                if (r < I_SQ) { idx = I_WOUT; wsoff = WS_OUT; }
                else { r -= I_SQ; if (r < I_SQ) { idx = I_EWG; wsoff = WS_EG; } else { r -= I_SQ; idx = I_EWP; K = PLE; wsoff = WS_EP; srcoff = (size_t)l * PLE * DM; } } } }
        transpose_item(argp()->in[idx] + srcoff, K, N, (bf16*)(ws + wsoff), mode, scr, r, F.lane);
    }
    const int gt = F.bid * NTHR + F.tid, NGT = F.G * NTHR;
    { bf16* wsm = (bf16*)(ws + WS_WSM) + (size_t)l * 4 * 128 * 128; const float* src = argp()->in[I_BWS] + (size_t)l * 4 * 128 * 128;
      for (int e = gt; e < 4 * 128 * 128; e += NGT) { const int j = e & 127, i = (e >> 7) & 127; wsm[e] = (bf16)f2bf(j <= i ? src[e] : 0.f); } }
    { bf16* pb = (bf16*)(ws + WS_PB); const float* pp = argp()->in[I_PP] + (size_t)l * MP * PLE; const float* ps = argp()->in[I_PS] + (size_t)l * MS * PLE;
      for (int e = gt; e < MPAD * PLE / 4; e += NGT) { const int row = e >> 6, c4 = (e & 63) * 4;
          f32x4 v = (f32x4){0.f, 0.f, 0.f, 0.f};
          if (row < MP) v = *(const f32x4*)(pp + (size_t)row * PLE + c4); else if (row < MV) v = *(const f32x4*)(ps + (size_t)(row - MP) * PLE + c4);
          v2u o; o.x = pk2(v.x, v.y); o.y = pk2(v.z, v.w); *(v2u*)(pb + (size_t)row * PLE + c4) = o; } }
}

template <bool FIRST, int NS = 0, bool GATE = false>
__device__ __forceinline__ void norm_pass(const float* y, float c, const float* gpost, const float* gpre) {
    const Frame F = mkframe();
    const int gw = F.bid * NWAVES + F.wave, NGW = F.G * NWAVES;
    bf16* XN = (bf16*)(argp()->ws + WS_XN);
    f32x4 gq[4], gp[4];
#pragma unroll
    for (int j = 0; j < 4; ++j) { gq[j] = *(const f32x4*)(gpre + 4 * F.lane + 256 * j); gp[j] = FIRST ? (f32x4){0.f, 0.f, 0.f, 0.f} : *(const f32x4*)(gpost + 4 * F.lane + 256 * j); }
    for (int row = gw; row < MV; row += NGW) {
        float* xo = argp()->out + (size_t)row * DM + 4 * F.lane;
        f32x4 xv[4];
        if (FIRST) { const float* xi = (row < MP ? argp()->in[I_XP] + (size_t)row * DM : argp()->in[I_XS] + (size_t)(row - MP) * DM) + 4 * F.lane;
#pragma unroll
            for (int j = 0; j < 4; ++j) xv[j] = *(const f32x4*)(xi + 256 * j);
        } else {
            const float* yr = y + (size_t)row * DM + 4 * F.lane; f32x4 yv[4]; float ss = 0.f;
#pragma unroll
            for (int j = 0; j < 4; ++j) { yv[j] = *(const f32x4*)(yr + 256 * j); xv[j] = *(const f32x4*)(xo + 256 * j); }
            if (NS > 0 && row >= MP) { const float* ys = (const float*)(argp()->ws + WS_YS) + (size_t)(row - MP) * DM + 4 * F.lane;
#pragma unroll
                for (int j = 0; j < 4; ++j) { f32x4 sv = *(const f32x4*)(ys + 256 * j);
                    for (int q = 1; q < NS; ++q) sv = sv + *(const f32x4*)(ys + (size_t)q * 256 * DM + 256 * j);
                    if (GATE) { const f32x4 pe = *(const f32x4*)((const float*)(argp()->ws + WS_ACT) + (size_t)row * DM + 4 * F.lane + 256 * j); sv.x = sigm(sv.x) * pe.x; sv.y = sigm(sv.y) * pe.y; sv.z = sigm(sv.z) * pe.z; sv.w = sigm(sv.w) * pe.w; }
                    yv[j] = sv; } }
#pragma unroll
            for (int j = 0; j < 4; ++j) ss += (yv[j].x * yv[j].x + yv[j].y * yv[j].y) + (yv[j].z * yv[j].z + yv[j].w * yv[j].w);
            const float r = c * rsqrtf(wave_sum(ss) * (1.f / DM) + EPS);
#pragma unroll
            for (int j = 0; j < 4; ++j) xv[j] = xv[j] + yv[j] * r * gp[j];
        }
        float s2 = 0.f;
#pragma unroll
        for (int j = 0; j < 4; ++j) { *(f32x4*)(xo + 256 * j) = xv[j]; s2 += (xv[j].x * xv[j].x + xv[j].y * xv[j].y) + (xv[j].z * xv[j].z + xv[j].w * xv[j].w); }
        const float r2 = rsqrtf(wave_sum(s2) * (1.f / DM) + EPS);
        bf16* xr = XN + (size_t)row * DM + 4 * F.lane;
#pragma unroll
        for (int j = 0; j < 4; ++j) { const f32x4 o = xv[j] * r2 * gq[j]; v2u w; w.x = pk2(o.x, o.y); w.y = pk2(o.z, o.w); *(v2u*)(xr + 256 * j) = w; }
    }
}

__device__ __forceinline__ void mix_b_unit(const Frame& F, int l, int ck, int h, const bf16* Z, bf16* MIXO) {
    typedef short bf16x8 __attribute__((ext_vector_type(8)));
    constexpr int VS = 136;
    LAS bf16* VT = (LAS bf16*)F.lds;
    const int t0 = ck * 128, lane = F.lane;
    { const f32x2 g = *(const f32x2*)(argp()->in[I_BLNG] + (l * 4 + h) * 128 + 2 * lane), b = *(const f32x2*)(argp()->in[I_BLNB] + (l * 4 + h) * 128 + 2 * lane);
#pragma unroll 2
      for (int i = 0; i < 16; ++i) { const int j = F.wave * 16 + i;
          const unsigned w = *(const unsigned*)(Z + (size_t)(t0 + j) * DIN + 1280 + h * 128 + 2 * lane);
          const float a0 = gelu_t(bf2f(w & 0xffffu)), a1 = gelu_t(bf2f(w >> 16));
          const float mean = wave_sum(a0 + a1) * (1.f / 128.f), d0 = a0 - mean, d1 = a1 - mean;
          const float rstd = rsqrtf(wave_sum(d0 * d0 + d1 * d1) * (1.f / 128.f) + EPS);
          VT[(2 * lane) * VS + j] = (bf16)f2bf(d0 * rstd * g.x + b.x); VT[(2 * lane + 1) * VS + j] = (bf16)f2bf(d1 * rstd * g.y + b.y); } }
    __syncthreads();
    const int i0 = F.wave * 16, fr = lane & 15, fq = lane >> 4, nk = (i0 + 16 + 31) >> 5;
    const bf16* Wb = (const bf16*)(argp()->ws + WS_WSM) + ((size_t)(l * 4 + h) * 128 + i0 + fr) * 128 + 8 * fq;
    f32x4 acc[8];
#pragma unroll
    for (int db = 0; db < 8; ++db) acc[db] = (f32x4){0.f, 0.f, 0.f, 0.f};
#pragma unroll 1
    for (int kb = 0; kb < nk; ++kb) {
        const bf16x8 wf = *(const bf16x8*)(Wb + kb * 32);
#pragma unroll
        for (int db = 0; db < 8; ++db) { const bf16x8 vf = *(const LAS bf16x8*)(VT + (db * 16 + fr) * VS + kb * 32 + 8 * fq);
            acc[db] = __builtin_amdgcn_mfma_f32_16x16x32_bf16(vf, wf, acc[db], 0, 0, 0); }
    }
    const float bi = argp()->in[I_BBIAS][(l * 4 + h) * 128 + i0 + fr];
    const size_t row = (size_t)(t0 + i0 + fr);
    const bf16* zu = Z + row * DIN + 768 + h * 128 + 4 * fq; bf16* mo = MIXO + row * DM + 256 + h * 128 + 4 * fq;
#pragma unroll
    for (int db = 0; db < 8; ++db) { const v2u uu = *(const v2u*)(zu + db * 16);
        const float y0 = gelu_t(bf2f(uu.x & 0xffffu)) * (acc[db].x + bi), y1 = gelu_t(bf2f(uu.x >> 16)) * (acc[db].y + bi), y2 = gelu_t(bf2f(uu.y & 0xffffu)) * (acc[db].z + bi), y3 = gelu_t(bf2f(uu.y >> 16)) * (acc[db].w + bi);
        v2u w; w.x = pk2(y0, y1); w.y = pk2(y2, y3); *(v2u*)(mo + db * 16) = w; }
    __syncthreads();
}

__device__ __forceinline__ void mix_ac_unit(const Frame& F, int l, int tb, const bf16* Z, bf16* MIXO) {
    const int t0 = tb * 64, b = t0 >> 11, pos0 = t0 & 2047, c = F.tid & 255, half = F.tid >> 8;
    { const float* cw = argp()->in[I_ACW] + l * 3 * 256; const float w0 = cw[c], w1 = cw[256 + c], w2 = cw[512 + c];
      const int ts = half * 32; float f2 = 0.f, f1 = 0.f;
      if (pos0 + ts - 2 >= 0) { const size_t row = (size_t)(t0 + ts - 2); f2 = bf2f(Z[row * DIN + 256 + c]) * bf2f(Z[row * DIN + c]); }
      if (pos0 + ts - 1 >= 0) { const size_t row = (size_t)(t0 + ts - 1); f1 = bf2f(Z[row * DIN + 256 + c]) * bf2f(Z[row * DIN + c]); }
      float* cap = argp()->out + O_CAP + (size_t)((l * 8 + b) * 2) * 256 + c;
      for (int i = 0; i < 32; ++i) { const size_t row = (size_t)(t0 + ts + i); const int p = pos0 + ts + i;
          const float av = bf2f(Z[row * DIN + c]), ac = bf2f(Z[row * DIN + 256 + c]), ab = bf2f(Z[row * DIN + 512 + c]);
          const float fa = ac * av; MIXO[row * DM + c] = (bf16)f2bf(ab * (w0 * f2 + w1 * f1 + w2 * fa));
          if (p >= SEQ - 2) cap[(p - (SEQ - 2)) * 256] = fa;
          f2 = f1; f1 = fa; } }
    LAS float* FC = (LAS float*)F.lds;
    { float* ccp = argp()->out + O_CCP + (size_t)((l * 8 + b) * 30) * 256 + c;
      for (int r = half; r < 94; r += 2) { const int p = pos0 - 30 + r; float fc = 0.f;
          if (p >= 0) { const size_t row = (size_t)(t0 - 30 + r); fc = bf2f(Z[row * DIN + 1792 + c]) * sigm(bf2f(Z[row * DIN + 2048 + c]));
              if (r >= 30 && p >= SEQ - 30) ccp[(p - (SEQ - 30)) * 256] = fc; }
          FC[r * 256 + c] = fc; } }
    __syncthreads();
    { const float* cw = argp()->in[I_CCW] + l * 31 * 256 + c; float w[31];
#pragma unroll
      for (int k = 0; k < 31; ++k) w[k] = cw[k * 256];
      float acc[32]; const float cb = argp()->in[I_CCB][l * 256 + c];
#pragma unroll
      for (int tt = 0; tt < 32; ++tt) acc[tt] = cb;
#pragma unroll
      for (int s = 0; s < 62; ++s) { const float f = FC[(half * 32 + s) * 256 + c];
#pragma unroll
          for (int tt = 0; tt < 32; ++tt) { if (s - tt >= 0 && s - tt <= 30) acc[tt] += w[s - tt] * f; } }
      __syncthreads();
#pragma unroll
      for (int tt = 0; tt < 32; ++tt) FC[(half * 32 + tt) * 256 + c] = acc[tt]; }
    __syncthreads();
    { const f32x4 g4 = *(const f32x4*)(argp()->in[I_CLNG] + l * 256 + 4 * F.lane), b4 = *(const f32x4*)(argp()->in[I_CLNB] + l * 256 + 4 * F.lane);
      for (int i = 0; i < 8; ++i) { const int t = F.wave * 8 + i; const f32x4 o = *(const LAS f32x4*)(FC + t * 256 + 4 * F.lane);
          const float mean = wave_sum((o.x + o.y) + (o.z + o.w)) * (1.f / 256.f); const f32x4 dd = o - mean;
          const float rstd = rsqrtf(wave_sum((dd.x * dd.x + dd.y * dd.y) + (dd.z * dd.z + dd.w * dd.w)) * (1.f / 256.f) + EPS);
          f32x4 yv = dd * rstd * g4 + b4; yv.x *= sigm(yv.x); yv.y *= sigm(yv.y); yv.z *= sigm(yv.z); yv.w *= sigm(yv.w);
          v2u w; w.x = pk2(yv.x, yv.y); w.y = pk2(yv.z, yv.w); *(v2u*)(MIXO + (size_t)(t0 + t) * DM + 768 + 4 * F.lane) = w; } }
    __syncthreads();
}

__device__ __forceinline__ void mix_sample_row(const Frame& F, int l, int s, const bf16* Z, bf16* MIXO) {
    const int lane = F.lane; const size_t R = (size_t)(MP + s); const bf16* z = Z + R * DIN; bf16* mo = MIXO + R * DM;
    {
      const int c = 4 * lane; const v2u zv = *(const v2u*)(z + c), zc = *(const v2u*)(z + 256 + c), zb = *(const v2u*)(z + 512 + c);
      const float* cw = argp()->in[I_ACW] + l * 3 * 256 + c; const f32x4 w0 = *(const f32x4*)cw, w1 = *(const f32x4*)(cw + 256), w2 = *(const f32x4*)(cw + 512);
      const float* st = argp()->in[I_SA] + ((size_t)(l * MS + s) * 2) * 256 + c; const f32x4 h0 = *(const f32x4*)st, h1 = *(const f32x4*)(st + 256);
      f32x4 av = {bf2f(zv.x & 0xffffu), bf2f(zv.x >> 16), bf2f(zv.y & 0xffffu), bf2f(zv.y >> 16)}, ac = {bf2f(zc.x & 0xffffu), bf2f(zc.x >> 16), bf2f(zc.y & 0xffffu), bf2f(zc.y >> 16)},
            ab = {bf2f(zb.x & 0xffffu), bf2f(zb.x >> 16), bf2f(zb.y & 0xffffu), bf2f(zb.y >> 16)};
      const f32x4 fa = ac * av, ya = ab * (w0 * h0 + w1 * h1 + w2 * fa);
      v2u w; w.x = pk2(ya.x, ya.y); w.y = pk2(ya.z, ya.w); *(v2u*)(mo + c) = w;
      float* cas = argp()->out + O_CAS + ((size_t)(l * MS + s) * 2) * 256 + c; *(f32x4*)cas = h1; *(f32x4*)(cas + 256) = fa; }
    {
      float* vs = argp()->out + O_VS + (size_t)(l * MS + s) * 512;
#pragma unroll
      for (int h = 0; h < 4; ++h) { const int d = 2 * lane;
          const unsigned wv = *(const unsigned*)(z + 1280 + h * 128 + d), wu = *(const unsigned*)(z + 768 + h * 128 + d);
          const f32x2 g = *(const f32x2*)(argp()->in[I_BLNG] + (l * 4 + h) * 128 + d), bb = *(const f32x2*)(argp()->in[I_BLNB] + (l * 4 + h) * 128 + d);
          const float a0 = gelu_t(bf2f(wv & 0xffffu)), a1 = gelu_t(bf2f(wv >> 16));
          const float mean = wave_sum(a0 + a1) * (1.f / 128.f), d0 = a0 - mean, d1 = a1 - mean;
          const float rstd = rsqrtf(wave_sum(d0 * d0 + d1 * d1) * (1.f / 128.f) + EPS);
          const float v0 = d0 * rstd * g.x + bb.x, v1 = d1 * rstd * g.y + bb.y;
          *(f32x2*)(vs + h * 128 + d) = (f32x2){v0, v1};
          const float w00 = argp()->in[I_BWS][(size_t)(l * 4 + h) * 128 * 128], bi = argp()->in[I_BBIAS][(l * 4 + h) * 128];
          const float y0 = gelu_t(bf2f(wu & 0xffffu)) * (w00 * v0 + bi), y1 = gelu_t(bf2f(wu >> 16)) * (w00 * v1 + bi);
          *(unsigned*)(mo + 256 + h * 128 + d) = pk2(y0, y1); } }
    {
      const int c = 4 * lane; const v2u zv = *(const v2u*)(z + 1792 + c), zg = *(const v2u*)(z + 2048 + c);
      f32x4 fc = {bf2f(zv.x & 0xffffu) * sigm(bf2f(zg.x & 0xffffu)), bf2f(zv.x >> 16) * sigm(bf2f(zg.x >> 16)), bf2f(zv.y & 0xffffu) * sigm(bf2f(zg.y & 0xffffu)), bf2f(zv.y >> 16) * sigm(bf2f(zg.y >> 16))};
      const float* cw = argp()->in[I_CCW] + l * 31 * 256 + c; const float* st = argp()->in[I_SC] + ((size_t)(l * MS + s) * 30) * 256 + c;
      float* ccs = argp()->out + O_CCS + ((size_t)(l * MS + s) * 30) * 256 + c;
      f32x4 acc = *(const f32x4*)(argp()->in[I_CCB] + l * 256 + c);
      for (int k = 0; k < 30; ++k) { const f32x4 hv = *(const f32x4*)(st + k * 256); acc = acc + *(const f32x4*)(cw + k * 256) * hv; if (k >= 1) *(f32x4*)(ccs + (k - 1) * 256) = hv; }
      acc = acc + *(const f32x4*)(cw + 30 * 256) * fc; *(f32x4*)(ccs + 29 * 256) = fc;
      const float mean = wave_sum((acc.x + acc.y) + (acc.z + acc.w)) * (1.f / 256.f); const f32x4 dd = acc - mean;
      const float rstd = rsqrtf(wave_sum((dd.x * dd.x + dd.y * dd.y) + (dd.z * dd.z + dd.w * dd.w)) * (1.f / 256.f) + EPS);
      f32x4 yv = dd * rstd * *(const f32x4*)(argp()->in[I_CLNG] + l * 256 + c) + *(const f32x4*)(argp()->in[I_CLNB] + l * 256 + c);
      yv.x *= sigm(yv.x); yv.y *= sigm(yv.y); yv.z *= sigm(yv.z); yv.w *= sigm(yv.w);
      v2u w; w.x = pk2(yv.x, yv.y); w.y = pk2(yv.z, yv.w); *(v2u*)(mo + 768 + c) = w; }
}

__device__ __forceinline__ void mixer_phase(int l) {
    const Frame F = mkframe();
    const bf16* Z = (const bf16*)(argp()->ws + WS_ACT); bf16* MIXO = (bf16*)(argp()->ws + WS_XN);
    constexpr int NB_U = 128 * 4, NAC_U = MP / 64, NS_U = MS / NWAVES, NU = NB_U + NAC_U + NS_U;
    for (int u = F.bid; u < NU; u += F.G) {
        const Frame Fu = mkframe(); asm volatile("" : "+s"(l));
        if (u < NB_U) {
#ifndef NO_MB
 mix_b_unit(Fu, l, u >> 2, u & 3, Z, MIXO);
#endif
 }
        else if (u < NB_U + NAC_U) {
#ifndef NO_MAC
 mix_ac_unit(Fu, l, u - NB_U, Z, MIXO);
#endif
 }
        else {
#ifndef NO_MS
 mix_sample_row(Fu, l, (u - NB_U - NAC_U) * NWAVES + Fu.wave, Z, MIXO);
#endif
 }
    }
}

#define XB_TMO      128
#define XB_XCNT(j)  (256  + 64 * (j))
#define XB_XSUB(j)  (1280 + 64 * (j))
#define XB_XGEN(j)  (2304 + 64 * (j))
#define XB_TOP      3328
#define XB_TOPGEN   3392
#define XCD_BAR_WORDS 3456
#define XB_SPIN_CAP (1u << 18)

__device__ __forceinline__ unsigned xb_ld(unsigned* p)              { return __hip_atomic_load(p, __ATOMIC_RELAXED, __HIP_MEMORY_SCOPE_AGENT); }
__device__ __forceinline__ unsigned xb_add(unsigned* p, unsigned v) { return __hip_atomic_fetch_add(p, v, __ATOMIC_RELAXED, __HIP_MEMORY_SCOPE_AGENT); }
__device__ __forceinline__ unsigned xb_xcc_id() { return (unsigned)__builtin_amdgcn_s_getreg((3 << 11) | 20) & 0xFu; }
#define XB_SPIN(cond, bar) do { unsigned _sp = 0; while (cond) { __builtin_amdgcn_s_sleep(1); \
    if ((++_sp & 255u) == 0u) { if (xb_ld(&(bar)[XB_TMO])) break; if (_sp > XB_SPIN_CAP) { atomicAdd(&(bar)[XB_TMO], 1u); break; } } } } while (0)

struct XcdBarrier {
    unsigned* bar; unsigned x;
    volatile LAS unsigned* st;
};

__device__ __forceinline__ XcdBarrier xcd_barrier_post(unsigned* bar, volatile LAS unsigned* st) {
    XcdBarrier b; b.bar = bar; b.x = xb_xcc_id(); b.st = st;
    if (threadIdx.x == 0) (void)xb_add(&bar[XB_XCNT(b.x)], 1u);
    return b;
}
__device__ __forceinline__ void xcd_barrier_complete(unsigned* bar, unsigned x, unsigned& nloc, unsigned& nx) {
    const unsigned G = gridDim.x * gridDim.y * gridDim.z;
    unsigned sum, cnt, mine, sp = 0u;
    for (;;) {
        sum = 0u; cnt = 0u; mine = 0u;
#pragma unroll
        for (unsigned j = 0; j < 16; ++j) { const unsigned c = xb_ld(&bar[XB_XCNT(j)]); sum += c; cnt += (c > 0u) ? 1u : 0u; mine = (j == x) ? c : mine; }
        if (sum == G) break;
        __builtin_amdgcn_s_sleep(1);
        if ((++sp & 255u) == 0u) { if (xb_ld(&bar[XB_TMO])) break; if (sp > XB_SPIN_CAP) { atomicAdd(&bar[XB_TMO], 1u); break; } }
    }
    nloc = mine > 0u ? mine : 1u; nx = cnt > 0u ? cnt : 1u;
}

__device__ __forceinline__ void xcd_barrier(const XcdBarrier& b) {
    asm volatile("s_waitcnt vmcnt(0)" ::: "memory");
    __syncthreads();
    if (threadIdx.x == 0) {
        unsigned* bar = b.bar;
        __builtin_amdgcn_s_waitcnt(0);
        unsigned nloc = b.st[0], nx = b.st[1];
        if (nloc == 0u) { xcd_barrier_complete(bar, b.x, nloc, nx); b.st[0] = nloc; b.st[1] = nx; }
        const unsigned old = xb_add(&bar[XB_XSUB(b.x)], 1u);
        const unsigned gen = old / nloc;
        if (old + 1u == (gen + 1u) * nloc) {
            __builtin_amdgcn_fence(__ATOMIC_RELEASE, "agent");
            asm volatile("s_waitcnt vmcnt(0)" ::: "memory");
            const unsigned og = xb_add(&bar[XB_TOP], 1u);
            const unsigned tg = og / nx;
            if (og + 1u == (tg + 1u) * nx) xb_add(&bar[XB_TOPGEN], 1u);
            else XB_SPIN(xb_ld(&bar[XB_TOPGEN]) == tg, bar);
            __builtin_amdgcn_fence(__ATOMIC_ACQUIRE, "agent");
            xb_add(&bar[XB_XGEN(b.x)], 1u);
            asm volatile("s_waitcnt vmcnt(0)" ::: "memory");
        } else {
            XB_SPIN(xb_ld(&bar[XB_XGEN(b.x)]) == gen, bar);
            __builtin_amdgcn_fence(__ATOMIC_ACQUIRE, "agent");
            asm volatile("s_waitcnt vmcnt(0)" ::: "memory");
        }
    }
    __syncthreads();
}

constexpr int CW_BAR = 4096;
__device__ __forceinline__ void grid_barrier() {
    extern __shared__ __attribute__((aligned(16))) unsigned char lds_raw[];
    XcdBarrier b; b.bar = (unsigned*)(argp()->ws + WS_CTL) + CW_BAR; b.x = xb_xcc_id(); b.st = (volatile LAS unsigned*)((LAS unsigned char*)lds_raw + 131072);
    xcd_barrier(b);
}
#ifndef GEMM_REP
#define GEMM_REP 1
#endif
#ifndef SYNC_REP
#define SYNC_REP 1
#endif
#ifndef MIX_REP
#define MIX_REP 1
#endif
#ifndef CONV_REP
#define CONV_REP 1
#endif
#define GSYNC() do { _Pragma("unroll 1") for (int rs_ = 0; rs_ < SYNC_REP; ++rs_) grid_barrier(); } while (0)
__global__ void __launch_bounds__(NTHR, 2) mega_fwd(Args a_unused) {
    extern __shared__ __attribute__((aligned(16))) unsigned char lds_raw[];
    cg::grid_group grid = cg::this_grid();
    if (threadIdx.x < 64) ((LAS unsigned*)((LAS unsigned char*)lds_raw + 131072))[threadIdx.x] = 0u;
    __syncthreads();
    (void)xcd_barrier_post((unsigned*)(argp()->ws + WS_CTL) + CW_BAR, (volatile LAS unsigned*)((LAS unsigned char*)lds_raw + 131072));
#define ws (argp()->ws)
#define XN ((bf16*)(ws + WS_XN))
#define ACT ((bf16*)(ws + WS_ACT))
#define Y ((float*)(ws + WS_Y))
#define PB ((bf16*)(ws + WS_PB))
#define PE ((float*)(ws + WS_ACT))
#define YS ((float*)(ws + WS_YS))
#ifndef NO_CONV
_Pragma("unroll 1") for (int rep_ = 0; rep_ < CONV_REP; ++rep_) { __syncthreads(); convert_layer(0); }
#endif
    { const Frame F = mkframe(); const int gt = F.bid * NTHR + F.tid, NGT = F.G * NTHR; v4u* p = (v4u*)(XN + (size_t)MV * DM);
      for (int e = gt; e < (MPAD - MV) * DM / 8; e += NGT) p[e] = (v4u){0u, 0u, 0u, 0u}; }
    norm_pass<true>(nullptr, 0.f, nullptr, argp()->in[I_F1PRE]);
    grid.sync();
#pragma unroll 1
    for (int l = 0; l < 2; ++l) {
#pragma unroll 1
        for (int f = 0; f < 2; ++f) {
            _Pragma("unroll 1") for (int rep_ = 0; rep_ < GEMM_REP; ++rep_) { pg8::Gemm g{XN, (const bf16*)(ws + (f ? WS_GU1 : WS_GU0)), MPAD, NGU, DM, DM}; pg8::StaticOrderT<MPAD, NGU> S; S.init((int)gridDim.x, (int)blockIdx.x);
              pg8::EpiSwiGLU E{ACT, DFF};
              pg8::gemm_phase<pg8::EpiSwiGLU, pg8::StaticOrderT<MPAD, NGU>, true, true, DM>((LAS unsigned char*)lds_raw, g, S, E); }
            GSYNC();
            _Pragma("unroll 1") for (int rep_ = 0; rep_ < GEMM_REP; ++rep_) { pg8::Gemm g{ACT, (const bf16*)(ws + (f ? WS_D1 : WS_D0)), MP, DM, DFF, DFF}; pg8::StaticOrderT<MP, DM> S; S.init((int)gridDim.x, (int)blockIdx.x);
              pg8::EpiF32 E{Y, DM};
              pg8::gemm_phase<pg8::EpiF32, pg8::StaticOrderT<MP, DM>, true, true, DFF>((LAS unsigned char*)lds_raw, g, S, E); }
            _Pragma("unroll 1") for (int rep_ = 0; rep_ < GEMM_REP; ++rep_) { pg8::Gemm g{ACT, (const bf16*)(ws + (f ? WS_D1 : WS_D0)), 256, DM, 256, DFF}; pg8::SplitOrder<DM, 11> S; S.init((int)gridDim.x, (int)blockIdx.x, MP / 256);
              pg8::EpiPart E{YS, DM};
              pg8::gemm_phase<pg8::EpiPart, pg8::SplitOrder<DM, 11>, true, true, 256>((LAS unsigned char*)lds_raw, g, S, E); }
            GSYNC();
            if (f == 0) {
                norm_pass<false, 11>(Y, 0.5f, argp()->in[I_F1POST] + l * DM, argp()->in[I_MPRE] + l * DM);
                GSYNC();
                _Pragma("unroll 1") for (int rep_ = 0; rep_ < GEMM_REP; ++rep_) { pg8::Gemm g{XN, (const bf16*)(ws + WS_IN), MPAD, DIN, DM, DM}; pg8::StaticOrderT<MPAD, DIN> S; S.init((int)gridDim.x, (int)blockIdx.x);
                  pg8::EpiBf16<0> E{ACT, DIN, nullptr, 0, 0, 1.f};
                  pg8::gemm_phase<pg8::EpiBf16<0>, pg8::StaticOrderT<MPAD, DIN>, true, true, DM>((LAS unsigned char*)lds_raw, g, S, E); }
                GSYNC();
_Pragma("unroll 1") for (int rep_ = 0; rep_ < MIX_REP; ++rep_) { __syncthreads(); mixer_phase(l); }
                GSYNC();
                _Pragma("unroll 1") for (int rep_ = 0; rep_ < GEMM_REP; ++rep_) { pg8::Gemm g{XN, (const bf16*)(ws + WS_OUT), MP, DM, DM, DM}; pg8::StaticOrderT<MP, DM> S; S.init((int)gridDim.x, (int)blockIdx.x);
                  pg8::EpiF32 E{Y, DM};
                  pg8::gemm_phase<pg8::EpiF32, pg8::StaticOrderT<MP, DM>, true, true, DM>((LAS unsigned char*)lds_raw, g, S, E); }
                _Pragma("unroll 1") for (int rep_ = 0; rep_ < GEMM_REP; ++rep_) { pg8::Gemm g{XN, (const bf16*)(ws + WS_OUT), 256, DM, 256, DM}; pg8::SplitOrder<DM, 4> S; S.init((int)gridDim.x, (int)blockIdx.x, MP / 256);
                  pg8::EpiPart E{YS, DM};
                  pg8::gemm_phase<pg8::EpiPart, pg8::SplitOrder<DM, 4>, true, true, 256>((LAS unsigned char*)lds_raw, g, S, E); }
                GSYNC();
                norm_pass<false, 4>(Y, 1.f, argp()->in[I_MPOST] + l * DM, argp()->in[I_F2PRE] + l * DM);
                GSYNC();
            } else {
                norm_pass<false, 11>(Y, 0.5f, argp()->in[I_F2POST] + l * DM, argp()->in[I_EPRE] + l * DM);
                __syncthreads();
                _Pragma("unroll 1") for (int rep_ = 0; rep_ < GEMM_REP; ++rep_) { pg8::Gemm g{PB, (const bf16*)(ws + WS_EP), MP, DM, PLE, PLE}; pg8::StaticOrderT<MP, DM> S; S.init((int)gridDim.x, (int)blockIdx.x);
                  pg8::EpiF32 E{PE, DM};
                  pg8::gemm_phase<pg8::EpiF32, pg8::StaticOrderT<MP, DM>, true, true, PLE>((LAS unsigned char*)lds_raw, g, S, E); }
                _Pragma("unroll 1") for (int rep_ = 0; rep_ < GEMM_REP; ++rep_) { pg8::Gemm g{PB, (const bf16*)(ws + WS_EP), 256, DM, PLE, PLE}; pg8::SplitOrder<DM, 1> S; S.init((int)gridDim.x, (int)blockIdx.x, MP / 256);
                  pg8::EpiF32 E{PE, DM};
                  pg8::gemm_phase<pg8::EpiF32, pg8::SplitOrder<DM, 1>, true, true, PLE>((LAS unsigned char*)lds_raw, g, S, E); }
                GSYNC();
                _Pragma("unroll 1") for (int rep_ = 0; rep_ < GEMM_REP; ++rep_) { pg8::Gemm g{XN, (const bf16*)(ws + WS_EG), MP, DM, DM, DM}; pg8::StaticOrderT<MP, DM> S; S.init((int)gridDim.x, (int)blockIdx.x);
                  pg8::EpiGate E{Y, PE, DM};
                  pg8::gemm_phase<pg8::EpiGate, pg8::StaticOrderT<MP, DM>, true, true, DM>((LAS unsigned char*)lds_raw, g, S, E); }
                _Pragma("unroll 1") for (int rep_ = 0; rep_ < GEMM_REP; ++rep_) { pg8::Gemm g{XN, (const bf16*)(ws + WS_EG), 256, DM, 256, DM}; pg8::SplitOrder<DM, 4> S; S.init((int)gridDim.x, (int)blockIdx.x, MP / 256);
                  pg8::EpiPart E{YS, DM};
                  pg8::gemm_phase<pg8::EpiPart, pg8::SplitOrder<DM, 4>, true, true, 256>((LAS unsigned char*)lds_raw, g, S, E); }
                GSYNC();
#ifndef NO_CONV
                if (l == 0) { _Pragma("unroll 1") for (int rep_ = 0; rep_ < CONV_REP; ++rep_) { __syncthreads(); convert_layer(1); } }
#endif
                norm_pass<false, 4, true>(Y, 1.f, argp()->in[I_EPOST] + l * DM, argp()->in[I_F1PRE] + (l == 0 ? DM : 0));
                GSYNC();
            }
        }
    }
}

#undef ws
#undef XN
#undef ACT
#undef Y
#undef PB
#undef PE
#undef YS
extern "C" void kernel_launch(void* const* d_in, const int* in_sizes, int n_in, void* d_out, int out_size, void* d_ws, size_t ws_size, hipStream_t stream) {
    static int grid = 0;
    if (grid == 0) {
        int dev = 0, cus = 0, per_cu = 0;
        if (n_in != 33 || ws_size < WS_END) { fprintf(stderr, "kernel_launch: unexpected n_in %d / ws_size %zu\n", n_in, ws_size); grid = -1; return; }
        hipGetDevice(&dev); hipDeviceGetAttribute(&cus, hipDeviceAttributeMultiprocessorCount, dev);
        if (hipFuncSetAttribute((const void*)mega_fwd, hipFuncAttributeMaxDynamicSharedMemorySize, LDS_BYTES) != hipSuccess) { fprintf(stderr, "kernel_launch: hipFuncSetAttribute failed\n"); grid = -1; return; }
        if (hipOccupancyMaxActiveBlocksPerMultiprocessor(&per_cu, (const void*)mega_fwd, NTHR, LDS_BYTES) != hipSuccess || per_cu < 1) { fprintf(stderr, "kernel_launch: occupancy query says %d\n", per_cu); grid = -1; return; }
        grid = cus;
    }
    if (grid < 0) return;
    hipMemsetAsync((char*)d_ws + WS_CTL, 0, CTL_ZERO_BYTES, stream);
    Args a{};
    for (int i = 0; i < 33; ++i) a.in[i] = (const float*)d_in[i];
    a.out = (float*)d_out; a.ws = (unsigned char*)d_ws;
    void* kargs[] = {&a};
    hipError_t e = hipLaunchCooperativeKernel((const void*)mega_fwd, dim3(grid), dim3(NTHR), kargs, LDS_BYTES, stream);
    if (e != hipSuccess) fprintf(stderr, "kernel_launch: cooperative launch failed: %s (grid %d)\n", hipGetErrorString(e), grid);
}
```
